# Optimizing an MI355X kernel written in HIP

```python
import jax
import jax.numpy as jnp
from jax import lax
import numpy as np

D_MODEL = 1024
BATCH = 8
SEQ = 4096
DEPTH = 1

GM_WIDTH = 1024
GM_GROUPS = 8
GM_GROUP_DIM = GM_WIDTH // GM_GROUPS
GM_CHUNK = 128

MLA_HEADS = 16
MLA_NOPE = 64
MLA_ROPE = 32
MLA_V = 64
MLA_Q_LORA = 384
MLA_KV_LORA = 256
ROPE_THETA = 10000.0
Q_BLOCK = 128

MEM_LEN = 256
MEM_HEADS = 4
MEM_HEAD_DIM = D_MODEL // MEM_HEADS

N_GROUPS = 8
EXPERTS_PER_GROUP = 8
N_EXPERTS = N_GROUPS * EXPERTS_PER_GROUP
TOP_K = 2
D_EXPERT = 256
MOE_BLOCK = 128

DEEPNORM_ALPHA = (2 * DEPTH) ** 0.25
DEEPNORM_BETA = (8 * DEPTH) ** -0.25
LN_EPS = 1e-5
RMS_EPS = 1e-6
MAX_POS_OFFSET = 2048

IN_SPLITS = (
    GM_WIDTH,
    2 * GM_WIDTH,
    2 * GM_WIDTH + MLA_Q_LORA,
    2 * GM_WIDTH + MLA_Q_LORA + MLA_KV_LORA,
    2 * GM_WIDTH + MLA_Q_LORA + MLA_KV_LORA + MLA_ROPE,
    2 * GM_WIDTH + MLA_Q_LORA + MLA_KV_LORA + MLA_ROPE + D_MODEL,
)
IN_COLS = IN_SPLITS[-1] + D_MODEL

kernel_name = "hybrid_gmlp_mla_memxattn_hmoe_deepnorm"


def layer_norm(x, g, b):
    xf = x.astype(jnp.float32)
    mu = jnp.mean(xf, axis=-1, keepdims=True)
    var = jnp.mean(jnp.square(xf - mu), axis=-1, keepdims=True)
    return ((xf - mu) * lax.rsqrt(var + LN_EPS) * g + b).astype(x.dtype)


def rms_norm(x, g):
    xf = x.astype(jnp.float32)
    return (xf * lax.rsqrt(jnp.mean(jnp.square(xf), axis=-1, keepdims=True) + RMS_EPS) * g).astype(x.dtype)


def rope(x, positions):
    half = MLA_ROPE // 2
    inv_freq = ROPE_THETA ** (-jnp.arange(half, dtype=jnp.float32) / half)
    ang = positions.astype(jnp.float32)[..., None] * inv_freq
    ang = ang.reshape(ang.shape[:2] + (1,) * (x.ndim - 3) + (half,))
    cos, sin = jnp.cos(ang), jnp.sin(ang)
    x1 = x[..., :half].astype(jnp.float32)
    x2 = x[..., half:].astype(jnp.float32)
    return jnp.concatenate([x1 * cos - x2 * sin, x2 * cos + x1 * sin], axis=-1).astype(x.dtype)


def gmlp_branch(u, v, ln_g, ln_b, w_s, b_s):
    B, S, _ = v.shape
    v = layer_norm(v, ln_g, ln_b)
    vc = v.reshape(B, S // GM_CHUNK, GM_CHUNK, GM_GROUPS, GM_GROUP_DIM)
    causal = jnp.tril(jnp.ones((GM_CHUNK, GM_CHUNK), dtype=bool))
    w = jnp.where(causal, w_s, 0).astype(v.dtype)
    mixed = jnp.einsum('gts,bcsgd->bctgd', w, vc) + b_s.T[None, None, :, :, None]
    return u * mixed.reshape(B, S, GM_WIDTH)


def mla_branch(c_q, c_kv, k_rope_raw, positions, q_norm_g, kv_norm_g, w_uq, w_uk, w_uv):
    B, S, _ = c_q.shape
    q = (rms_norm(c_q, q_norm_g) @ w_uq).reshape(B, S, MLA_HEADS, MLA_NOPE + MLA_ROPE)
    q_nope = q[..., :MLA_NOPE]
    q_rope = rope(q[..., MLA_NOPE:], positions)
    ckv = rms_norm(c_kv, kv_norm_g)
    k_nope = (ckv @ w_uk).reshape(B, S, MLA_HEADS, MLA_NOPE)
    v = (ckv @ w_uv).reshape(B, S, MLA_HEADS, MLA_V)
    k_rope = rope(k_rope_raw, positions)
    scale = (MLA_NOPE + MLA_ROPE) ** -0.5
    n_blocks = S // Q_BLOCK
    key_idx = jnp.arange(S)

    def to_blocks(t):
        return jnp.moveaxis(t.reshape((B, n_blocks, Q_BLOCK) + t.shape[2:]), 1, 0)

    def attend(args):
        qn, qr, blk = args
        s = (jnp.einsum('bqhd,bkhd->bhqk', qn, k_nope, preferred_element_type=jnp.float32)
             + jnp.einsum('bqhr,bkr->bhqk', qr, k_rope, preferred_element_type=jnp.float32)) * scale
        q_idx = blk * Q_BLOCK + jnp.arange(Q_BLOCK)
        s = jnp.where(key_idx[None, :] <= q_idx[:, None], s, -jnp.inf)
        p = jax.nn.softmax(s, axis=-1).astype(v.dtype)
        return jnp.einsum('bhqk,bkhd->bqhd', p, v)

    o = lax.map(attend, (to_blocks(q_nope), to_blocks(q_rope), jnp.arange(n_blocks)))
    return jnp.moveaxis(o, 0, 1).reshape(B, S, MLA_HEADS * MLA_V)


def memory_cross_attention(x, mem, w_mq, w_mk, w_mv, w_mo):
    B, S, _ = x.shape
    M = mem.shape[1]
    q = (x @ w_mq).reshape(B, S, MEM_HEADS, MEM_HEAD_DIM)
    k = (mem @ w_mk).reshape(B, M, MEM_HEADS, MEM_HEAD_DIM)
    v = (mem @ w_mv).reshape(B, M, MEM_HEADS, MEM_HEAD_DIM)
    s = jnp.einsum('bqhd,bmhd->bhqm', q, k, preferred_element_type=jnp.float32) * (MEM_HEAD_DIM ** -0.5)
    p = jax.nn.softmax(s, axis=-1).astype(v.dtype)
    o = jnp.einsum('bhqm,bmhd->bqhd', p, v).reshape(B, S, MEM_HEADS * MEM_HEAD_DIM)
    return o @ w_mo


def swiglu(xb, w_gate, w_up, w_down):
    return (jax.nn.silu(xb @ w_gate) * (xb @ w_up)) @ w_down


def hierarchical_moe(x, w_group_router, b_group_router, w_expert_router, b_expert_router,
                     w_exp_gate, w_exp_up, w_exp_down):
    B, S, D = x.shape
    T = B * S
    xf = x.reshape(T, D)
    g_logits = (xf @ w_group_router).astype(jnp.float32) + b_group_router
    g_prob = jax.nn.softmax(g_logits, axis=-1)
    g_sel = jnp.argmax(g_logits, axis=-1)
    g_w = jnp.take_along_axis(g_prob, g_sel[:, None], axis=-1)
    e_logits = ((xf @ w_expert_router).astype(jnp.float32) + b_expert_router).reshape(T, N_GROUPS, EXPERTS_PER_GROUP)
    e_logits = jnp.take_along_axis(e_logits, g_sel[:, None, None], axis=1)[:, 0]
    top_val, top_loc = lax.top_k(e_logits, TOP_K)
    top_w = jax.nn.softmax(top_val, axis=-1) * g_w
    top_e = g_sel[:, None] * EXPERTS_PER_GROUP + top_loc

    A = T * TOP_K
    flat_e = top_e.reshape(A)
    flat_tok = jnp.repeat(jnp.arange(T, dtype=jnp.int32), TOP_K)
    flat_w = top_w.reshape(A)
    order = jnp.argsort(flat_e)
    sorted_e, sorted_tok, sorted_w = flat_e[order], flat_tok[order], flat_w[order]
    counts = jnp.zeros((N_EXPERTS,), jnp.int32).at[flat_e].add(1)
    starts = jnp.cumsum(counts) - counts
    padded = (counts + MOE_BLOCK - 1) // MOE_BLOCK * MOE_BLOCK
    padded_ends = jnp.cumsum(padded)
    padded_starts = padded_ends - padded
    dest = padded_starts[sorted_e] + (jnp.arange(A, dtype=jnp.int32) - starts[sorted_e])
    P = A + N_EXPERTS * MOE_BLOCK
    n_blocks = P // MOE_BLOCK
    xd = jnp.zeros((P, D), x.dtype).at[dest].set(xf[sorted_tok])
    block_start = jnp.arange(n_blocks, dtype=jnp.int32) * MOE_BLOCK
    block_e = jnp.minimum(jnp.sum(padded_ends[None, :] <= block_start[:, None], axis=1), N_EXPERTS - 1)

    def run_block(args):
        xb, e = args
        return swiglu(xb, w_exp_gate[e], w_exp_up[e], w_exp_down[e])

    yd = lax.map(run_block, (xd.reshape(n_blocks, MOE_BLOCK, D), block_e)).reshape(P, D)
    contrib = yd[dest] * sorted_w[:, None].astype(yd.dtype)
    y = jnp.zeros((T, D), yd.dtype).at[sorted_tok].add(contrib)
    return y.reshape(B, S, D)


def hybrid_layer(x, mem, positions, w_in, b_in, gm_ln_g, gm_ln_b, gm_w_s, gm_b_s, w_gm_out,
                 mla_q_norm_g, mla_kv_norm_g, w_uq, w_uk, w_uv, w_mla_out, w_o, ln1_g, ln1_b,
                 w_mq, w_mk, w_mv, w_mo, ln2_g, ln2_b,
                 w_group_router, b_group_router, w_expert_router, b_expert_router,
                 w_exp_gate, w_exp_up, w_exp_down, ln3_g, ln3_b):
    proj = x @ w_in + b_in
    u, v, c_q, c_kv, k_rope_raw, gate_gm, gate_mla = jnp.split(proj, IN_SPLITS, axis=-1)
    y_gm = gmlp_branch(jax.nn.gelu(u, approximate=False), jax.nn.gelu(v, approximate=False),
                       gm_ln_g, gm_ln_b, gm_w_s, gm_b_s) @ w_gm_out
    y_mla = mla_branch(c_q, c_kv, k_rope_raw, positions, mla_q_norm_g, mla_kv_norm_g,
                       w_uq, w_uk, w_uv) @ w_mla_out
    merged = jax.nn.sigmoid(gate_gm) * y_gm + jax.nn.sigmoid(gate_mla) * y_mla
    x = layer_norm(DEEPNORM_ALPHA * x + merged @ w_o, ln1_g, ln1_b)
    x = layer_norm(DEEPNORM_ALPHA * x + memory_cross_attention(x, mem, w_mq, w_mk, w_mv, w_mo), ln2_g, ln2_b)
    y_moe = hierarchical_moe(x, w_group_router, b_group_router, w_expert_router, b_expert_router,
                             w_exp_gate, w_exp_up, w_exp_down)
    return layer_norm(DEEPNORM_ALPHA * x + y_moe, ln3_g, ln3_b)


def setup_inputs(seed: int = 0) -> dict:
    key = jax.random.key(seed)
    keys = jax.random.split(key, 40)
    counter = [0]

    def next_key():
        k = keys[counter[0]]
        counter[0] += 1
        return k

    def nrm(shape, scale):
        return jax.random.normal(next_key(), shape, jnp.float32) * scale

    def gain(shape):
        return 1.0 + nrm(shape, 0.02)

    L = DEPTH
    beta = DEEPNORM_BETA
    x = nrm((BATCH, SEQ, D_MODEL), 1.0)
    mem = nrm((BATCH, MEM_LEN, D_MODEL), 1.0)
    positions = (jnp.arange(SEQ, dtype=jnp.int32)[None, :]
                 + jax.random.randint(next_key(), (BATCH, 1), 0, MAX_POS_OFFSET, dtype=jnp.int32))
    return {
        "x": x,
        "mem": mem,
        "positions": positions,
        "w_in": nrm((L, D_MODEL, IN_COLS), D_MODEL ** -0.5),
        "b_in": nrm((L, IN_COLS), 0.02),
        "gm_ln_g": gain((L, GM_WIDTH)),
        "gm_ln_b": nrm((L, GM_WIDTH), 0.02),
        "gm_w_s": jnp.tril(nrm((L, GM_GROUPS, GM_CHUNK, GM_CHUNK), GM_CHUNK ** -0.5)),
        "gm_b_s": gain((L, GM_GROUPS, GM_CHUNK)),
        "w_gm_out": nrm((L, GM_WIDTH, D_MODEL), GM_WIDTH ** -0.5 * beta),
        "mla_q_norm_g": gain((L, MLA_Q_LORA)),
        "mla_kv_norm_g": gain((L, MLA_KV_LORA)),
        "w_uq": nrm((L, MLA_Q_LORA, MLA_HEADS * (MLA_NOPE + MLA_ROPE)), MLA_Q_LORA ** -0.5),
        "w_uk": nrm((L, MLA_KV_LORA, MLA_HEADS * MLA_NOPE), MLA_KV_LORA ** -0.5),
        "w_uv": nrm((L, MLA_KV_LORA, MLA_HEADS * MLA_V), MLA_KV_LORA ** -0.5 * beta),
        "w_mla_out": nrm((L, MLA_HEADS * MLA_V, D_MODEL), (MLA_HEADS * MLA_V) ** -0.5 * beta),
        "w_o": nrm((L, D_MODEL, D_MODEL), D_MODEL ** -0.5 * beta),
        "ln1_g": gain((L, D_MODEL)),
        "ln1_b": nrm((L, D_MODEL), 0.02),
        "w_mq": nrm((L, D_MODEL, MEM_HEADS * MEM_HEAD_DIM), D_MODEL ** -0.5),
        "w_mk": nrm((L, D_MODEL, MEM_HEADS * MEM_HEAD_DIM), D_MODEL ** -0.5),
        "w_mv": nrm((L, D_MODEL, MEM_HEADS * MEM_HEAD_DIM), D_MODEL ** -0.5 * beta),
        "w_mo": nrm((L, MEM_HEADS * MEM_HEAD_DIM, D_MODEL), D_MODEL ** -0.5 * beta),
        "ln2_g": gain((L, D_MODEL)),
        "ln2_b": nrm((L, D_MODEL), 0.02),
        "w_group_router": nrm((L, D_MODEL, N_GROUPS), D_MODEL ** -0.5),
        "b_group_router": nrm((L, N_GROUPS), 0.01),
        "w_expert_router": nrm((L, D_MODEL, N_EXPERTS), D_MODEL ** -0.5),
        "b_expert_router": nrm((L, N_EXPERTS), 0.01),
        "w_exp_gate": nrm((L, N_EXPERTS, D_MODEL, D_EXPERT), D_MODEL ** -0.5 * beta),
        "w_exp_up": nrm((L, N_EXPERTS, D_MODEL, D_EXPERT), D_MODEL ** -0.5 * beta),
        "w_exp_down": nrm((L, N_EXPERTS, D_EXPERT, D_MODEL), D_EXPERT ** -0.5 * beta),
        "ln3_g": gain((L, D_MODEL)),
        "ln3_b": nrm((L, D_MODEL), 0.02),
    }


def reference(x, mem, positions, w_in, b_in, gm_ln_g, gm_ln_b, gm_w_s, gm_b_s, w_gm_out,
              mla_q_norm_g, mla_kv_norm_g, w_uq, w_uk, w_uv, w_mla_out, w_o, ln1_g, ln1_b,
              w_mq, w_mk, w_mv, w_mo, ln2_g, ln2_b,
              w_group_router, b_group_router, w_expert_router, b_expert_router,
              w_exp_gate, w_exp_up, w_exp_down, ln3_g, ln3_b):
    h = x
    for l in range(DEPTH):
        h = hybrid_layer(h, mem, positions, w_in[l], b_in[l], gm_ln_g[l], gm_ln_b[l], gm_w_s[l], gm_b_s[l],
                         w_gm_out[l], mla_q_norm_g[l], mla_kv_norm_g[l], w_uq[l], w_uk[l], w_uv[l],
                         w_mla_out[l], w_o[l], ln1_g[l], ln1_b[l],
                         w_mq[l], w_mk[l], w_mv[l], w_mo[l], ln2_g[l], ln2_b[l],
                         w_group_router[l], b_group_router[l], w_expert_router[l], b_expert_router[l],
                         w_exp_gate[l], w_exp_up[l], w_exp_down[l], ln3_g[l], ln3_b[l])
    return h
```

```cpp
#include <hip/hip_runtime.h>
#include <cstdio>
#include <cstdint>

#ifndef MK_N_LAUNCHES
#define MK_N_LAUNCHES 16
#endif

namespace pg8 {
#define PG8_LAS __attribute__((address_space(3)))
typedef unsigned short bf16_t;
typedef short bf16x8 __attribute__((ext_vector_type(8)));
typedef float f32x4 __attribute__((ext_vector_type(4)));
typedef unsigned u32x4 __attribute__((ext_vector_type(4)));
constexpr int BM = 256, BK = 64, HALF = 128, HTB = HALF * BK * 2  , STAGE_BYTES = 8 * HTB, NXCD = 8, WGM = 8;

__host__ __device__ __forceinline__ int lds_byte(int r, int c) { const int st = (r >> 4) * 2 + (c >> 5), rr = r & 15, cc = c & 31, ob = rr * 64 + cc * 2; return st * 1024 + (ob ^ (((ob >> 9) & 1) << 5)); }
__host__ __device__ __forceinline__ void stage_rc(int b, int& R, int& C) { const int st = b / 1024, sb = b % 1024, swz = sb ^ (((sb >> 9) & 1) << 5); R = (st >> 1) * 16 + swz / 64; C = (st & 1) * 32 + (swz % 64) / 2; }
__host__ __device__ __forceinline__ int perm32(int rho) { const int n = rho >> 4, i = rho & 15; return 8 * (i >> 2) + 4 * n + (i & 3); }

struct Unit { int pm, pn, e; };
struct Gemm { int lda, ldb, K; };

__device__ __forceinline__ unsigned cvt_pk_bf16(float lo, float hi) { unsigned r; asm volatile("v_cvt_pk_bf16_f32 %0, %1, %2" : "=v"(r) : "v"(lo), "v"(hi)); return r; }
typedef float f32x2 __attribute__((ext_vector_type(2)));
__device__ __forceinline__ f32x2 gelu_pk(f32x2 v) {
    const f32x2 av = __builtin_elementwise_abs(v), d = av * 0.2316418882f + 1.0f;
    f32x2 t; t.x = __builtin_amdgcn_rcpf(d.x); t.y = __builtin_amdgcn_rcpf(d.y);
    f32x2 q = t * 0.5307027145f + (-0.7265760135f); q = q * t + 0.7107068705f; q = q * t + (-0.142248368f); q = q * t + 0.127414796f; q = q * t;
    const f32x2 s = (v * v) * (-0.72134752044f);
    f32x2 e; e.x = __builtin_amdgcn_exp2f(s.x); e.y = __builtin_amdgcn_exp2f(s.y);
    const f32x2 m = v * (q * e), r = v - m;
    f32x2 o; o.x = v.x < 0.f ? m.x : r.x; o.y = v.y < 0.f ? m.y : r.y; return o;
}

template <class F> struct EpiF8 {
    static constexpr bool PERM = true, BLOCK = false; F f;
    __device__ __forceinline__ void operator()(const f32x4 (&acc)[2][2][4][2], const Unit& u, int wr, int wc, int fr, int fq) const {
        const int row0 = u.pm * BM + wr * 64 + fr, col0 = u.pn * BM + wc * 32 + 8 * fq;
#pragma unroll
        for (int ai = 0; ai < 2; ++ai)
#pragma unroll
            for (int m = 0; m < 4; ++m)
#pragma unroll
                for (int bj = 0; bj < 2; ++bj) {
                    float v[8] = {acc[ai][bj][m][0][0], acc[ai][bj][m][0][1], acc[ai][bj][m][0][2], acc[ai][bj][m][0][3], acc[ai][bj][m][1][0], acc[ai][bj][m][1][1], acc[ai][bj][m][1][2], acc[ai][bj][m][1][3]};
                    f(u, row0 + ai * HALF + m * 16, col0 + bj * HALF, v); if (bj == 1) asm volatile("" ::: "memory"); }
    }
};

template <class Epi, class Sched, bool ALIGN_EPI = false, bool SP2 = false>
__device__ __forceinline__ void gemm_phase(PG8_LAS unsigned char* lds, PG8_LAS unsigned char* ldsx, const Gemm g, const Sched& S, const Epi& E) {
    static_assert(!Epi::BLOCK || ALIGN_EPI, "block-level epilogues need both halves aligned");
    int tid = threadIdx.x; asm volatile("" : "+v"(tid));
    const int wid = __builtin_amdgcn_readfirstlane(tid >> 6), lane = tid & 63, wr = wid >> 2, wc = wid & 3, fr = lane & 15, fq = lane >> 4;
    const int K = g.K, nt = K / BK, lda = g.lda, ldb = g.ldb;
    unsigned voffA[2], voffB[2];
#pragma unroll
    for (int i = 0; i < 2; ++i) { int R, C; stage_rc(tid * 16 + i * 8192, R, C); const int Rb = Epi::PERM ? ((R & ~31) + perm32(R & 31)) : R;
        voffA[i] = (unsigned)(R * lda + C) * 2u; voffB[i] = (unsigned)(Rb * ldb + C) * 2u; }
    const size_t kstep = (size_t)(BK * 2);
    const size_t hstepA = (size_t)HALF * lda * 2, hstepB = (size_t)HALF * ldb * 2;
    const unsigned ldsw = (unsigned)wid * 1024u;
    const int aoff = lds_byte(wr * 64 + fr, fq * 8), boff = lds_byte(wc * 32 + fr, fq * 8);
#define PG8_SA(b, h) (((b) * 2 + (h)) * HTB)
#define PG8_SB(b, h) ((4 + (b) * 2 + (h)) * HTB)
#define PG8_STAGE(bufoff, gbase, voff) do { _Pragma("unroll") for (int _i = 0; _i < 2; ++_i) \
        __builtin_amdgcn_global_load_lds((const unsigned*)((const char*)(gbase) + (voff)[_i]), (PG8_LAS unsigned*)(lds + (bufoff) + ldsw + _i * 8192), 16, 0, 0); } while (0)
#define PG8_LDA(dst, b, h) do { _Pragma("unroll") for (int m = 0; m < 4; ++m) _Pragma("unroll") for (int k = 0; k < 2; ++k) dst[m][k] = *(const PG8_LAS bf16x8*)(lds + PG8_SA(b, h) + aoff + m * 2048 + k * 1024); } while (0)
#define PG8_LDB(dst, b, h) do { _Pragma("unroll") for (int n = 0; n < 2; ++n) _Pragma("unroll") for (int k = 0; k < 2; ++k) dst[n][k] = *(const PG8_LAS bf16x8*)(lds + PG8_SB(b, h) + boff + n * 2048 + k * 1024); } while (0)
#define PG8_MMA(ai, bj, At, Bt) do { __builtin_amdgcn_s_setprio(1); _Pragma("unroll") for (int m = 0; m < 4; ++m) _Pragma("unroll") for (int n = 0; n < 2; ++n) _Pragma("unroll") for (int k = 0; k < 2; ++k) \
        acc[ai][bj][m][n] = __builtin_amdgcn_mfma_f32_16x16x32_bf16(Bt[n][k], At[m][k], acc[ai][bj][m][n], 0, 0, 0); __builtin_amdgcn_s_setprio(0); } while (0)
#define PG8_WAIT_V(n) asm volatile("s_waitcnt vmcnt(" #n ")" ::: "memory")
#define PG8_WAIT_L(n) asm volatile("s_waitcnt lgkmcnt(" #n ")" ::: "memory")
#define PG8_BAR __builtin_amdgcn_s_barrier()
#define PG8_SCHED __builtin_amdgcn_sched_barrier(0)
    Unit cur, nxt; int ui = 0;
    if (!S.next(0, cur)) return;
    f32x4 acc[2][2][4][2];
#pragma unroll
    for (int a = 0; a < 2; ++a)
#pragma unroll
        for (int b = 0; b < 2; ++b)
#pragma unroll
            for (int m = 0; m < 4; ++m)
#pragma unroll
                for (int n = 0; n < 2; ++n) acc[a][b][m][n] = (f32x4){0.f, 0.f, 0.f, 0.f};
    bf16x8 At[4][2], B0[2][2], B1[2][2];
    const char* cA = S.ua(cur); const char* cB = S.ub(cur);
    if constexpr (SP2) {
        PG8_STAGE(PG8_SB(0, 0), cB, voffB); PG8_STAGE(PG8_SB(0, 1), cB + hstepB, voffB); PG8_STAGE(PG8_SA(0, 0), cA, voffA); PG8_STAGE(PG8_SA(0, 1), cA + hstepA, voffA);
        if (wr == 1) PG8_BAR;
        PG8_WAIT_V(2); PG8_BAR;
        PG8_STAGE(PG8_SB(1, 0), cB + kstep, voffB); PG8_STAGE(PG8_SA(1, 0), cA + kstep, voffA); PG8_STAGE(PG8_SB(1, 1), cB + hstepB + kstep, voffB);
        PG8_WAIT_V(6); PG8_BAR;
    } else {
        PG8_STAGE(PG8_SB(0, 0), cB, voffB); PG8_STAGE(PG8_SA(0, 0), cA, voffA); PG8_STAGE(PG8_SB(0, 1), cB + hstepB, voffB); PG8_STAGE(PG8_SA(0, 1), cA + hstepA, voffA);
        if (wr == 1) PG8_BAR;
        PG8_WAIT_V(4); PG8_BAR;
        PG8_STAGE(PG8_SB(1, 0), cB + kstep, voffB); PG8_STAGE(PG8_SA(1, 0), cA + kstep, voffA); PG8_STAGE(PG8_SB(1, 1), cB + hstepB + kstep, voffB);
        PG8_WAIT_V(6); PG8_BAR;
    }
    for (;;) {
        const bool has_next = S.next(ui + 1, nxt);
        const char* nA = has_next ? S.ua(nxt) : cA; const char* nB = has_next ? S.ub(nxt) : cB;
#pragma unroll 1
        for (int t = 0; t < nt; t += 2) {
            const bool last = (t == nt - 2);
            const char* a1 = cA + (size_t)(t + 1) * kstep;
            const char* a2 = last ? nA : cA + (size_t)(t + 2) * kstep; const char* b2 = last ? nB : cB + (size_t)(t + 2) * kstep;
            const char* a3 = a2 + kstep; const char* b3 = b2 + kstep;
            if constexpr (SP2) {
            PG8_LDB(B0, 0, 0); PG8_LDB(B1, 0, 1); PG8_SCHED; PG8_LDA(At, 0, 0); PG8_STAGE(PG8_SA(1, 1), a1 + hstepA, voffA);
            PG8_WAIT_V(8); PG8_WAIT_L(0); PG8_BAR; PG8_MMA(0, 0, At, B0); PG8_MMA(0, 1, At, B1); PG8_BAR; PG8_SCHED;
            PG8_LDA(At, 0, 1); PG8_STAGE(PG8_SB(0, 0), b2, voffB); PG8_STAGE(PG8_SB(0, 1), b2 + hstepB, voffB); PG8_STAGE(PG8_SA(0, 0), a2, voffA);
            PG8_WAIT_V(8); PG8_WAIT_L(0); PG8_BAR; PG8_MMA(1, 0, At, B0); PG8_MMA(1, 1, At, B1); PG8_BAR; PG8_SCHED;
            PG8_LDB(B0, 1, 0); PG8_LDB(B1, 1, 1); PG8_SCHED; PG8_LDA(At, 1, 0); PG8_STAGE(PG8_SA(0, 1), a2 + hstepA, voffA);
            PG8_WAIT_V(8); PG8_WAIT_L(0); PG8_BAR; PG8_MMA(0, 0, At, B0); PG8_MMA(0, 1, At, B1); PG8_BAR; PG8_SCHED;
            PG8_LDA(At, 1, 1); PG8_STAGE(PG8_SB(1, 0), b3, voffB); PG8_STAGE(PG8_SB(1, 1), b3 + hstepB, voffB); PG8_STAGE(PG8_SA(1, 0), a3, voffA);
            PG8_WAIT_V(8); PG8_WAIT_L(0); PG8_BAR; PG8_MMA(1, 0, At, B0); PG8_MMA(1, 1, At, B1); PG8_BAR; PG8_SCHED;
            } else {
            PG8_LDB(B0, 0, 0); PG8_SCHED; PG8_LDA(At, 0, 0); PG8_STAGE(PG8_SA(1, 1), a1 + hstepA, voffA);
            PG8_WAIT_L(8); PG8_BAR; PG8_WAIT_L(0); PG8_MMA(0, 0, At, B0); PG8_BAR; PG8_SCHED;
            PG8_LDB(B1, 0, 1); PG8_STAGE(PG8_SB(0, 0), b2, voffB);
            PG8_BAR; PG8_WAIT_L(0); PG8_MMA(0, 1, At, B1); PG8_BAR;
            PG8_LDA(At, 0, 1); PG8_STAGE(PG8_SA(0, 0), a2, voffA);
            PG8_BAR; PG8_WAIT_L(0); PG8_MMA(1, 0, At, B0); PG8_BAR; PG8_SCHED;
            PG8_STAGE(PG8_SB(0, 1), b2 + hstepB, voffB);
            PG8_WAIT_V(6); PG8_BAR; PG8_MMA(1, 1, At, B1); PG8_BAR;
            PG8_LDB(B0, 1, 0); PG8_SCHED; PG8_LDA(At, 1, 0); PG8_STAGE(PG8_SA(0, 1), a2 + hstepA, voffA);
            PG8_WAIT_L(8); PG8_BAR; PG8_WAIT_L(0); PG8_MMA(0, 0, At, B0); PG8_BAR; PG8_SCHED;
            PG8_LDB(B1, 1, 1); PG8_STAGE(PG8_SB(1, 0), b3, voffB);
            PG8_BAR; PG8_WAIT_L(0); PG8_MMA(0, 1, At, B1); PG8_BAR;
            PG8_LDA(At, 1, 1); PG8_STAGE(PG8_SA(1, 0), a3, voffA);
            PG8_BAR; PG8_WAIT_L(0); PG8_MMA(1, 0, At, B0); PG8_BAR; PG8_SCHED;
            PG8_STAGE(PG8_SB(1, 1), b3 + hstepB, voffB);
            PG8_WAIT_V(6); PG8_BAR; PG8_MMA(1, 1, At, B1); PG8_BAR;
            }
        }
        if constexpr (ALIGN_EPI) { if (wr == 0) PG8_BAR; }
        if constexpr (Epi::BLOCK) { E.block(acc, cur, wr, wc, fr, fq, ldsx, wid, lane); } else { E(acc, cur, wr, wc, fr, fq); }
        if (!has_next) break;
#pragma unroll
        for (int a = 0; a < 2; ++a)
#pragma unroll
            for (int b = 0; b < 2; ++b)
#pragma unroll
                for (int m = 0; m < 4; ++m)
#pragma unroll
                    for (int n = 0; n < 2; ++n) acc[a][b][m][n] = (f32x4){0.f, 0.f, 0.f, 0.f};
        cur = nxt; cA = nA; cB = nB; ++ui;
        if constexpr (ALIGN_EPI) { if (wr == 1) PG8_BAR; }
    }
    PG8_WAIT_V(0);
    if constexpr (!ALIGN_EPI) { if (wr == 0) PG8_BAR; }
    PG8_BAR;

#undef PG8_SA
#undef PG8_SB
#undef PG8_STAGE
#undef PG8_LDA
#undef PG8_LDB
#undef PG8_MMA
#undef PG8_WAIT_V
#undef PG8_WAIT_L
#undef PG8_BAR
#undef PG8_SCHED
}
}

constexpr int NWAVES = 8;
constexpr int BATCH = 8, SEQ = 4096, DM = 1024, M = BATCH * SEQ;
constexpr int NPROJ = 4864;
constexpr int PC_U = 0, PC_V = 1024, PC_G1 = 2048, PC_G2 = 3072, PC_CKV = 4096, PC_CQ = 4352, PC_KR = 4736;
constexpr int IN_COLS = 4768, SRC_CQ = 2048, SRC_CKV = 2432, SRC_KR = 2688, SRC_G1 = 2720, SRC_G2 = 3744;
constexpr int QLORA = 384, KVLORA = 256, NH = 16, DQK = 96, DV = 64, QW = NH * DQK;
constexpr int MEMLEN = 256, MROWS = BATCH * MEMLEN;
constexpr int NEXP = 64, DEXP = 256, XS_ROWS = 81920, MAXTILES = XS_ROWS / 256;
constexpr float ALPHA = 1.189207115002721f;
constexpr float LN_EPS = 1e-5f, RMS_EPS = 1e-6f;
constexpr float C2_MLA = 0.10206207261596577f * 1.4426950408889634f;
constexpr float C2_MEM = 0.0625f * 1.4426950408889634f;

constexpr size_t MiB = 1u << 20;
constexpr size_t WS_CTL = 0, CTL_ZERO_BYTES = 1 * MiB;
constexpr size_t WS_VSTAT = 1 * MiB, WS_RSQ = WS_VSTAT + 256 * 1024, WS_RSKV = WS_RSQ + 128 * 1024, WS_BIASP = WS_RSKV + 128 * 1024;
constexpr size_t WS_TOKE = 2 * MiB, WS_TOKW = WS_TOKE + 256 * 1024, WS_TOKP = WS_TOKW + 256 * 1024, WS_ROWW = WS_TOKP + 256 * 1024;
constexpr size_t WS_ROPE = 4 * MiB;
constexpr size_t WS_WIN = 8 * MiB, WS_WGM = 18 * MiB, WS_WMLA = 20 * MiB, WS_WO = 22 * MiB, WS_WMQN = 24 * MiB, WS_WMKV = 26 * MiB, WS_WMO = 30 * MiB;
constexpr size_t WS_WUQ = 32 * MiB, WS_WUKV = 34 * MiB, WS_WTRIL = 35 * MiB, WS_WRT = 35 * MiB + 512 * 1024, WS_MB = 36 * MiB;
constexpr size_t WS_KXVX = 40 * MiB, WS_WQK = 48 * MiB, WS_VW = 64 * MiB;
constexpr size_t WS_PROJ = 80 * MiB;
constexpr size_t WS_XB = 384 * MiB, WS_VH = 384 * MiB, WS_MG = 384 * MiB;
constexpr size_t WS_KN = 448 * MiB;
constexpr size_t WS_X1 = 80 * MiB, WS_X1B = 208 * MiB, WS_PX = 272 * MiB, WS_X2 = 336 * MiB, WS_WE2 = 464 * MiB;
constexpr size_t WS_XS = 80 * MiB, WS_HS = 240 * MiB, WS_YS = 80 * MiB;
constexpr size_t WS_END = 512 * MiB;
constexpr size_t OUT_QH = 0, OUT_KR = 96 * MiB, OUT_MG32 = 0, OUT_X2B = 0, OUT_WE1 = 64 * MiB;
constexpr int CW_BAR = 4096;
constexpr int CW_CNT = 16384;
constexpr int CW_NTILES = 16384 + 64;
constexpr int CW_TILEE = 16384 + 128;

constexpr int RING_BYTES = 131072, XSCR_OFF = 131072, MISC_OFF = 147200, LDS_BYTES = 147456;

#define GAS __attribute__((address_space(1)))
#define LAS __attribute__((address_space(3)))
typedef unsigned short bf16;
typedef unsigned v4u __attribute__((ext_vector_type(4)));
typedef unsigned v2u __attribute__((ext_vector_type(2)));
typedef float f32x4 __attribute__((ext_vector_type(4)));
typedef float f32x2 __attribute__((ext_vector_type(2)));
typedef float f32x16 __attribute__((ext_vector_type(16)));
typedef short bf16x8 __attribute__((ext_vector_type(8)));
typedef short s16x4 __attribute__((ext_vector_type(4)));
#define RLX_AGENT __ATOMIC_RELAXED, __HIP_MEMORY_SCOPE_AGENT
#define LDS_WAIT() asm volatile("s_waitcnt lgkmcnt(0)" ::: "memory")
#define VM_WAIT() asm volatile("s_waitcnt vmcnt(0)" ::: "memory")
__device__ __forceinline__ unsigned f2bf(float f) { unsigned u = __builtin_bit_cast(unsigned, f); return (u + 0x7fffu + ((u >> 16) & 1u)) >> 16; }
__device__ __forceinline__ unsigned pk2(float lo, float hi) { return f2bf(lo) | (f2bf(hi) << 16); }
__device__ __forceinline__ float bflo(unsigned w) { return __builtin_bit_cast(float, w << 16); }
__device__ __forceinline__ float bfhi(unsigned w) { return __builtin_bit_cast(float, w & 0xffff0000u); }
__device__ __forceinline__ void unpack8(const v4u w, float (&f)[8]) { f[0] = bflo(w.x); f[1] = bfhi(w.x); f[2] = bflo(w.y); f[3] = bfhi(w.y); f[4] = bflo(w.z); f[5] = bfhi(w.z); f[6] = bflo(w.w); f[7] = bfhi(w.w); }
__device__ __forceinline__ v4u pack8(const float (&f)[8]) { v4u w; w.x = pk2(f[0], f[1]); w.y = pk2(f[2], f[3]); w.z = pk2(f[4], f[5]); w.w = pk2(f[6], f[7]); return w; }
__device__ __forceinline__ float wave_sum(float v) {
#pragma unroll
    for (int o = 1; o < 64; o <<= 1) v += __shfl_xor(v, o);
    return v;
}

#define XB_TMO      128
#define XB_XCNT(j)  (256  + 64 * (j))
#define XB_XSUB(j)  (1280 + 64 * (j))
#define XB_XGEN(j)  (2304 + 64 * (j))
#define XB_TOP      3328
#define XB_TOPGEN   3392
#define XCD_BAR_WORDS 3456
#define XB_SPIN_CAP (1u << 18)
__device__ __forceinline__ unsigned xb_ld(unsigned* p)              { return __hip_atomic_load(p, __ATOMIC_RELAXED, __HIP_MEMORY_SCOPE_AGENT); }
__device__ __forceinline__ unsigned xb_add(unsigned* p, unsigned v) { return __hip_atomic_fetch_add(p, v, __ATOMIC_RELAXED, __HIP_MEMORY_SCOPE_AGENT); }
__device__ __forceinline__ unsigned xb_xcc_id() { return (unsigned)__builtin_amdgcn_s_getreg((3 << 11) | 20) & 0xFu; }
#define XB_SPIN(cond, bar) do { unsigned _sp = 0; while (cond) { __builtin_amdgcn_s_sleep(1); \
    if ((++_sp & 255u) == 0u) { if (xb_ld(&(bar)[XB_TMO])) break; if (_sp > XB_SPIN_CAP) { atomicAdd(&(bar)[XB_TMO], 1u); break; } } } } while (0)
struct XcdBarrier { unsigned* bar; unsigned x; volatile LAS unsigned* st; };
__device__ __forceinline__ XcdBarrier xcd_barrier_post(unsigned* bar, volatile LAS unsigned* st) {
    XcdBarrier b; b.bar = bar; b.x = xb_xcc_id(); b.st = st;
    if (threadIdx.x == 0) (void)xb_add(&bar[XB_XCNT(b.x)], 1u);
    return b;
}
__device__ __forceinline__ void xcd_barrier_complete(unsigned* bar, unsigned x, unsigned& nloc, unsigned& nx) {
    const unsigned G = gridDim.x * gridDim.y * gridDim.z;
    unsigned sum, cnt, mine, sp = 0u;
    for (;;) {
        sum = 0u; cnt = 0u; mine = 0u;
#pragma unroll
        for (unsigned j = 0; j < 16; ++j) { const unsigned c = xb_ld(&bar[XB_XCNT(j)]); sum += c; cnt += (c > 0u) ? 1u : 0u; mine = (j == x) ? c : mine; }
        if (sum == G) break;
        __builtin_amdgcn_s_sleep(1);
        if ((++sp & 255u) == 0u) { if (xb_ld(&bar[XB_TMO])) break; if (sp > XB_SPIN_CAP) { atomicAdd(&bar[XB_TMO], 1u); break; } }
    }
    nloc = mine > 0u ? mine : 1u; nx = cnt > 0u ? cnt : 1u;
}
__device__ __forceinline__ void xcd_barrier(const XcdBarrier& b) {
    asm volatile("s_waitcnt vmcnt(0)" ::: "memory");
    __syncthreads();
    if (threadIdx.x == 0) {
        unsigned* bar = b.bar;
        __builtin_amdgcn_s_waitcnt(0);
        unsigned nloc = b.st[0], nx = b.st[1];
        if (nloc == 0u) { xcd_barrier_complete(bar, b.x, nloc, nx); b.st[0] = nloc; b.st[1] = nx; }
        const unsigned old = xb_add(&bar[XB_XSUB(b.x)], 1u);
        const unsigned gen = old / nloc;
        if (old + 1u == (gen + 1u) * nloc) {
            __builtin_amdgcn_fence(__ATOMIC_RELEASE, "agent");
            asm volatile("s_waitcnt vmcnt(0)" ::: "memory");
            const unsigned og = xb_add(&bar[XB_TOP], 1u);
            const unsigned tg = og / nx;
            if (og + 1u == (tg + 1u) * nx) xb_add(&bar[XB_TOPGEN], 1u);
            else XB_SPIN(xb_ld(&bar[XB_TOPGEN]) == tg, bar);
            __builtin_amdgcn_fence(__ATOMIC_ACQUIRE, "agent");
            xb_add(&bar[XB_XGEN(b.x)], 1u);
            asm volatile("s_waitcnt vmcnt(0)" ::: "memory");
        } else {
            XB_SPIN(xb_ld(&bar[XB_XGEN(b.x)]) == gen, bar);
            __builtin_amdgcn_fence(__ATOMIC_ACQUIRE, "agent");
            asm volatile("s_waitcnt vmcnt(0)" ::: "memory");
        }
    }
    __syncthreads();
}

struct GenOrder {
    int nM, nN, nwg, G, c, mode, pmb;
    const char* A; const char* B; size_t tA, tB, bstride;
    const unsigned* tile_e;
    __device__ __forceinline__ void init(int M_, int N_, int G_, int c_, const void* A_, int lda, const void* B_, int ldb, int mode_ = 0, int pmb_ = 1, size_t bstride_ = 0) {
        nM = M_ / 256; nN = N_ / 256; nwg = nM * nN; G = G_; c = c_; mode = mode_; pmb = pmb_; A = (const char*)A_; B = (const char*)B_; tA = (size_t)512 * lda; tB = (size_t)512 * ldb; bstride = bstride_; tile_e = nullptr; }
    __device__ __forceinline__ bool next(int i, pg8::Unit& u) const {
        const long L = (long)i * G + c; if (L >= nwg) return false;
        if (mode == 4) { u.pm = (int)(L / nN); u.pn = (int)(L % nN); u.e = (int)__builtin_amdgcn_readfirstlane(__hip_atomic_load(tile_e + u.pm, RLX_AGENT)); return true; }
        int wgid = (int)L; { const int q = nwg / 8, r = nwg % 8, xcd = wgid % 8, off = wgid / 8; wgid = (xcd < r ? xcd * (q + 1) : r * (q + 1) + (xcd - r) * q) + off; }
        const int nig = 8 * nN, gid = wgid / nig, fm = gid * 8, gsz = (nM - fm) < 8 ? (nM - fm) : 8;
        u.pm = fm + ((wgid % nig) % gsz); u.pn = (wgid % nig) / gsz; u.e = 0; return true;
    }
    __device__ __forceinline__ const char* ua(const pg8::Unit& u) const {
        if (mode == 2) return A + (size_t)(u.pm >> 2) * tA + (size_t)(u.pm & 3) * 512;
        if (mode == 3) return A + (size_t)(u.pm & 3) * tA + (size_t)u.pn * 512;
        return A + (size_t)u.pm * tA;
    }
    __device__ __forceinline__ const char* ub(const pg8::Unit& u) const {
        if (mode == 1) return B + (size_t)u.pn * tB + (size_t)(u.pm / pmb) * bstride;
        if (mode == 2) return B + (size_t)u.pn * tB + (size_t)(u.pm & 3) * 512;
        if (mode == 3) return B + (size_t)(u.pm >> 2) * tB + (size_t)u.pn * 512;
        if (mode == 4) return B + (size_t)u.e * bstride + (size_t)u.pn * tB;
        return B + (size_t)u.pn * tB;
    }
};

__device__ __forceinline__ void st16(bf16* p, const float (&v)[8]) { *(v4u*)p = pack8(v); }
__device__ __forceinline__ float sigmoidf_(float x) { return __builtin_amdgcn_rcpf(1.0f + __builtin_amdgcn_exp2f(-1.4426950408889634f * x)); }
struct F_inproj {
    bf16* proj; const float* biasp;
    __device__ __forceinline__ void operator()(const pg8::Unit& u, int row, int col, float (&v)[8]) const {
        const f32x4 b0 = *(const f32x4*)(biasp + col), b1 = *(const f32x4*)(biasp + col + 4);
        v[0] += b0[0]; v[1] += b0[1]; v[2] += b0[2]; v[3] += b0[3]; v[4] += b1[0]; v[5] += b1[1]; v[6] += b1[2]; v[7] += b1[3];
        if (u.pn < 8) {
#pragma unroll
            for (int i = 0; i < 8; i += 2) { const pg8::f32x2 g = pg8::gelu_pk((pg8::f32x2){v[i], v[i + 1]}); v[i] = g.x; v[i + 1] = g.y; }
        } else if (u.pn < 16) {
#pragma unroll
            for (int i = 0; i < 8; ++i) v[i] = sigmoidf_(v[i]);
        }
        st16(proj + (size_t)row * NPROJ + col, v);
    }
};
struct F_q {
    bf16* qh; const float* rsq; const float* rope;
    __device__ __forceinline__ void operator()(const pg8::Unit&, int row, int col, float (&v)[8]) const {
        const float s = rsq[row] * C2_MLA; const int i0 = col % DQK;
        if (i0 >= 64) { const int j0 = (i0 - 64) >> 1; const f32x4 c0 = *(const f32x4*)(rope + ((size_t)row * 16 + j0) * 2), c1 = *(const f32x4*)(rope + ((size_t)row * 16 + j0) * 2 + 4);
            const float cs[8] = {c0[0], c0[1], c0[2], c0[3], c1[0], c1[1], c1[2], c1[3]};
#pragma unroll
            for (int e = 0; e < 4; ++e) { const float a = v[2 * e], b = v[2 * e + 1], c = cs[2 * e], sn = cs[2 * e + 1]; v[2 * e] = a * c - b * sn; v[2 * e + 1] = b * c + a * sn; } }
#pragma unroll
        for (int i = 0; i < 8; ++i) v[i] *= s;
        st16(qh + (size_t)row * QW + col, v);
    }
};
struct F_kv {
    bf16* kn; bf16* vh; const float* rskv;
    __device__ __forceinline__ void operator()(const pg8::Unit&, int row, int col, float (&v)[8]) const {
        const float s = rskv[row];
#pragma unroll
        for (int i = 0; i < 8; ++i) v[i] *= s;
        if (col < 1024) st16(kn + (size_t)row * 1024 + col, v); else st16(vh + (size_t)row * 1024 + (col - 1024), v);
    }
};
struct F_store {
    bf16* o; int ldo; float scale;
    __device__ __forceinline__ void operator()(const pg8::Unit&, int row, int col, float (&v)[8]) const {
#pragma unroll
        for (int i = 0; i < 8; ++i) v[i] *= scale;
        st16(o + (size_t)row * ldo + col, v);
    }
};
struct F_mg1 {
    const bf16* proj; float* mg32;
    __device__ __forceinline__ void operator()(const pg8::Unit&, int row, int col, float (&v)[8]) const {
        float g[8]; unpack8(*(const v4u*)(proj + (size_t)row * NPROJ + PC_G1 + col), g);
        float* o = mg32 + (size_t)row * 1024 + col;
        *(f32x4*)o = (f32x4){g[0] * v[0], g[1] * v[1], g[2] * v[2], g[3] * v[3]}; *(f32x4*)(o + 4) = (f32x4){g[4] * v[4], g[5] * v[5], g[6] * v[6], g[7] * v[7]};
    }
};
struct F_mg2 {
    const bf16* proj; const float* mg32; bf16* mg;
    __device__ __forceinline__ void operator()(const pg8::Unit&, int row, int col, float (&v)[8]) const {
        float g[8]; unpack8(*(const v4u*)(proj + (size_t)row * NPROJ + PC_G2 + col), g);
        const float* p = mg32 + (size_t)row * 1024 + col; const f32x4 a = *(const f32x4*)p, b = *(const f32x4*)(p + 4);
        float o[8] = {a[0] + g[0] * v[0], a[1] + g[1] * v[1], a[2] + g[2] * v[2], a[3] + g[3] * v[3], b[0] + g[4] * v[4], b[1] + g[5] * v[5], b[2] + g[6] * v[6], b[3] + g[7] * v[7]};
        st16(mg + (size_t)row * 1024 + col, o);
    }
};
struct F_res {
    const float* base; float* pre;
    __device__ __forceinline__ void operator()(const pg8::Unit&, int row, int col, float (&v)[8]) const {
        const float* p = base + (size_t)row * 1024 + col; const f32x4 a = *(const f32x4*)p, b = *(const f32x4*)(p + 4);
        float* o = pre + (size_t)row * 1024 + col;
        *(f32x4*)o = (f32x4){ALPHA * a[0] + v[0], ALPHA * a[1] + v[1], ALPHA * a[2] + v[2], ALPHA * a[3] + v[3]}; *(f32x4*)(o + 4) = (f32x4){ALPHA * b[0] + v[4], ALPHA * b[1] + v[5], ALPHA * b[2] + v[6], ALPHA * b[3] + v[7]};
    }
};
struct F_down {
    bf16* ys; const float* roww;
    __device__ __forceinline__ void operator()(const pg8::Unit&, int row, int col, float (&v)[8]) const {
        const float s = __hip_atomic_load(roww + row, RLX_AGENT);
#pragma unroll
        for (int i = 0; i < 8; ++i) v[i] *= s;
        st16(ys + (size_t)row * 1024 + col, v);
    }
};
struct EpiSwiglu {
    static constexpr bool PERM = true, BLOCK = false; bf16* hs;
    __device__ __forceinline__ void operator()(const pg8::f32x4 (&acc)[2][2][4][2], const pg8::Unit& u, int wr, int wc, int fr, int fq) const {
        const int row0 = u.pm * 256 + wr * 64 + fr, col0 = u.pn * 128 + wc * 32 + 8 * fq;
#pragma unroll
        for (int ai = 0; ai < 2; ++ai)
#pragma unroll
            for (int m = 0; m < 4; ++m) { float h[8];
#pragma unroll
                for (int n = 0; n < 2; ++n)
#pragma unroll
                    for (int e = 0; e < 4; ++e) { const float g = acc[ai][0][m][n][e], up = acc[ai][1][m][n][e]; h[4 * n + e] = g * sigmoidf_(g) * up; }
                st16(hs + (size_t)(row0 + ai * 128 + m * 16) * DEXP + col0, h); }
    }
};
struct EpiSoftmax {
    static constexpr bool PERM = true, BLOCK = true; bf16* px;
    __device__ __forceinline__ void block(pg8::f32x4 (&acc)[2][2][4][2], const pg8::Unit& u, int wr, int wc, int fr, int fq, LAS unsigned char* ldsx, int wid, int lane) const {
        LAS float* TM = (LAS float*)ldsx; LAS float* TS = (LAS float*)(ldsx + 4096);
#pragma unroll
        for (int ai = 0; ai < 2; ++ai)
#pragma unroll
            for (int m = 0; m < 4; ++m) { float mx = -3.0e38f;
#pragma unroll
                for (int bj = 0; bj < 2; ++bj)
#pragma unroll
                    for (int n = 0; n < 2; ++n)
#pragma unroll
                        for (int e = 0; e < 4; ++e) mx = fmaxf(mx, acc[ai][bj][m][n][e]);
                mx = fmaxf(mx, __shfl_xor(mx, 16)); mx = fmaxf(mx, __shfl_xor(mx, 32));
                if (fq == 0) TM[(ai * 128 + wr * 64 + m * 16 + fr) * 4 + wc] = mx; }
        asm volatile("s_waitcnt lgkmcnt(0)" ::: "memory"); __builtin_amdgcn_s_barrier(); asm volatile("" ::: "memory");
#pragma unroll
        for (int ai = 0; ai < 2; ++ai)
#pragma unroll
            for (int m = 0; m < 4; ++m) { const int r = ai * 128 + wr * 64 + m * 16 + fr; const f32x4 t = *(const LAS f32x4*)(TM + r * 4); const float mx = fmaxf(fmaxf(t[0], t[1]), fmaxf(t[2], t[3])); float s = 0.f;
#pragma unroll
                for (int bj = 0; bj < 2; ++bj)
#pragma unroll
                    for (int n = 0; n < 2; ++n)
#pragma unroll
                        for (int e = 0; e < 4; ++e) { const float p = __builtin_amdgcn_exp2f(acc[ai][bj][m][n][e] - mx); acc[ai][bj][m][n][e] = p; s += p; }
                s += __shfl_xor(s, 16); s += __shfl_xor(s, 32);
                if (fq == 0) TS[r * 4 + wc] = s; }
        asm volatile("s_waitcnt lgkmcnt(0)" ::: "memory"); __builtin_amdgcn_s_barrier(); asm volatile("" ::: "memory");
        const int col0 = u.pn * 256 + wc * 32 + 8 * fq;
#pragma unroll
        for (int ai = 0; ai < 2; ++ai)
#pragma unroll
            for (int m = 0; m < 4; ++m) { const int r = ai * 128 + wr * 64 + m * 16 + fr; const f32x4 t = *(const LAS f32x4*)(TS + r * 4); const float inv = 1.0f / ((t[0] + t[1]) + (t[2] + t[3]));
#pragma unroll
                for (int bj = 0; bj < 2; ++bj) { float o[8];
#pragma unroll
                    for (int n = 0; n < 2; ++n)
#pragma unroll
                        for (int e = 0; e < 4; ++e) o[4 * n + e] = acc[ai][bj][m][n][e] * inv;
                    st16(px + (size_t)(u.pm * 256 + r) * 1024 + col0 + bj * 128, o); } }
        asm volatile("s_waitcnt lgkmcnt(0)" ::: "memory"); __builtin_amdgcn_s_barrier(); asm volatile("" ::: "memory");
    }
};

template <class F>
__device__ __forceinline__ void tr_item(const float* W, int ldw, bf16* WT, int ldt, int k0, int n0, F srccol, const float* ksc, LAS float* scr, int lane) {
    const int sc = srccol(n0 + (lane & 31));
#pragma unroll 8
    for (int i = 0; i < 32; ++i) { const int kk = 2 * i + (lane >> 5); float val = (sc >= 0) ? W[(size_t)(k0 + kk) * ldw + sc] : 0.f; if (ksc) val *= ksc[k0 + kk]; scr[kk * 33 + (lane & 31)] = val; }
    LDS_WAIT(); asm volatile("" ::: "memory");
    const int c = lane & 7;
#pragma unroll
    for (int j = 0; j < 4; ++j) { const int n = (lane >> 3) + 8 * j; const LAS float* s = scr + (8 * c) * 33 + n;
        v4u o; o.x = pk2(s[0 * 33], s[1 * 33]); o.y = pk2(s[2 * 33], s[3 * 33]); o.z = pk2(s[4 * 33], s[5 * 33]); o.w = pk2(s[6 * 33], s[7 * 33]);
        *(v4u*)(WT + (size_t)(n0 + n) * ldt + k0 + 8 * c) = o; }
    LDS_WAIT(); asm volatile("" ::: "memory");
}
template <class F>
__device__ __forceinline__ void tr_matrix(const float* W, int K, int ldw, int Nd, bf16* WT, int ldt, int roff, F srccol, const float* ksc, LAS float* scr, int lane, int gw, int NGW) {
    const int nblk = Nd / 32, nitems = (K / 64) * nblk;
    for (int it = gw; it < nitems; it += NGW) { const int kb = it / nblk, nb = it % nblk; tr_item(W, ldw, WT + (size_t)roff * ldt, ldt, 64 * kb, 32 * nb, srccol, ksc, scr, lane); }
}
struct ColIdent { int off; __device__ __forceinline__ int operator()(int n) const { return n + off; } };
struct ColWin {
    __device__ __forceinline__ int operator()(int n) const {
        if (n < 2048) return n;
        if (n < 3072) return SRC_G1 + (n - 2048);
        if (n < 4096) return SRC_G2 + (n - 3072);
        if (n < 4352) return SRC_CKV + (n - 4096);
        if (n < 4736) return SRC_CQ + (n - 4352);
        if (n < 4768) { const int i = n - 4736; return SRC_KR + (i >> 1) + 16 * (i & 1); }
        return -1;
    }
};
struct ColWuq {
    __device__ __forceinline__ int operator()(int n) const { const int h = n / DQK, i = n % DQK; if (i < 64) return n; const int r = i - 64; return h * DQK + 64 + (r >> 1) + 16 * (r & 1); }
};
__device__ __forceinline__ void ln_row_store(f32x4 (&v)[4], const float* gam, const float* bet, float* of32, bf16* obf, int lane) {
    float s = 0.f;
#pragma unroll
    for (int j = 0; j < 4; ++j) s += (v[j][0] + v[j][1]) + (v[j][2] + v[j][3]);
    const float mean = wave_sum(s) * (1.f / 1024.f); float s2 = 0.f;
#pragma unroll
    for (int j = 0; j < 4; ++j) { v[j] = v[j] - mean; s2 += (v[j][0] * v[j][0] + v[j][1] * v[j][1]) + (v[j][2] * v[j][2] + v[j][3] * v[j][3]); }
    const float rstd = 1.0f / sqrtf(wave_sum(s2) * (1.f / 1024.f) + LN_EPS);
#pragma unroll
    for (int j = 0; j < 4; ++j) { const f32x4 g = *(const f32x4*)(gam + 256 * j + 4 * lane), b = *(const f32x4*)(bet + 256 * j + 4 * lane); const f32x4 o = v[j] * rstd * g + b;
        if (of32) *(f32x4*)(of32 + 256 * j + 4 * lane) = o;
        if (obf) { v2u w; w.x = pk2(o[0], o[1]); w.y = pk2(o[2], o[3]); *(v2u*)(obf + 256 * j + 4 * lane) = w; } }
}

constexpr int GM_TP = 136, GM_MP = 132, GM_MS_OFF = 36864;
__device__ __forceinline__ void gmlp_phase(LAS unsigned char* lds, bf16* proj, const float* vstat, const float* lng, const float* lnb, const bf16* wtril, const float* bs, int vcu, int G) {
    const int tid = threadIdx.x, lane = tid & 63, w = __builtin_amdgcn_readfirstlane(tid >> 6);
    LAS bf16* T = (LAS bf16*)lds; LAS float* MS = (LAS float*)(lds + GM_MS_OFF);
    for (int it = vcu; it < 2048; it += G) {
        const int rc = it >> 3, g = it & 7; const size_t row0 = (size_t)rc * 128;
#pragma unroll
        for (int q = 0; q < 4; ++q) { const int idx = tid + 512 * q, s = idx >> 4, dc = idx & 15;
            float x[8]; unpack8(*(const v4u*)(proj + (row0 + s) * NPROJ + PC_V + g * 128 + 8 * dc), x);
            const f32x2 st = *(const f32x2*)(vstat + (row0 + s) * 2);
            const f32x4 g0 = *(const f32x4*)(lng + g * 128 + 8 * dc), g1 = *(const f32x4*)(lng + g * 128 + 8 * dc + 4), b0 = *(const f32x4*)(lnb + g * 128 + 8 * dc), b1 = *(const f32x4*)(lnb + g * 128 + 8 * dc + 4);
            const float gg[8] = {g0[0], g0[1], g0[2], g0[3], g1[0], g1[1], g1[2], g1[3]}, bb[8] = {b0[0], b0[1], b0[2], b0[3], b1[0], b1[1], b1[2], b1[3]};
#pragma unroll
            for (int i = 0; i < 8; ++i) T[(8 * dc + i) * GM_TP + s] = (bf16)f2bf((x[i] - st.x) * st.y * gg[i] + bb[i]); }
        __syncthreads();
        f32x4 acc[8];
#pragma unroll
        for (int db = 0; db < 8; ++db) acc[db] = (f32x4){0.f, 0.f, 0.f, 0.f};
        const int nks = (16 * w + 15) / 32 + 1;
        for (int ks = 0; ks < nks; ++ks) {
            const bf16x8 a = *(const bf16x8*)(wtril + ((size_t)(g * 128 + 16 * w + (lane & 15))) * 128 + 32 * ks + 8 * (lane >> 4));
#pragma unroll
            for (int db = 0; db < 8; ++db) { const bf16x8 b = *(const LAS bf16x8*)(T + (16 * db + (lane & 15)) * GM_TP + 32 * ks + 8 * (lane >> 4)); acc[db] = __builtin_amdgcn_mfma_f32_16x16x32_bf16(a, b, acc[db], 0, 0, 0); }
        }
#pragma unroll
        for (int r = 0; r < 4; ++r) { const int t = 16 * w + 4 * (lane >> 4) + r; const float bsv = bs[g * 128 + t];
#pragma unroll
            for (int db = 0; db < 8; ++db) MS[t * GM_MP + 16 * db + (lane & 15)] = acc[db][r] + bsv; }
        __syncthreads();
#pragma unroll
        for (int q = 0; q < 4; ++q) { const int idx = tid + 512 * q, t = idx >> 4, dc = idx & 15;
            const f32x4 m0 = *(const LAS f32x4*)(MS + t * GM_MP + 8 * dc), m1 = *(const LAS f32x4*)(MS + t * GM_MP + 8 * dc + 4);
            bf16* up = proj + (row0 + t) * NPROJ + PC_U + g * 128 + 8 * dc; float x[8]; unpack8(*(const v4u*)up, x);
            const float z[8] = {x[0] * m0[0], x[1] * m0[1], x[2] * m0[2], x[3] * m0[3], x[4] * m1[0], x[5] * m1[1], x[6] * m1[2], x[7] * m1[3]};
            st16(up, z); }
    }
    __syncthreads();
}

namespace att {
constexpr int KSLOT = 12288, VSLOT = 8192, L_K = 0, L_V = 2 * KSLOT, L_WS = L_V + 2 * VSLOT, L_OST = L_WS + 8 * 256, L_END = L_OST + 8 * 4096;
__device__ __forceinline__ int crow(int r, int hi) { return (r & 3) + 8 * (r >> 2) + 4 * hi; }
__device__ __forceinline__ unsigned cvtpk(float lo, float hi) { typedef float f2 __attribute__((ext_vector_type(2))); typedef __bf16 b2 __attribute__((ext_vector_type(2))); f2 v = {lo, hi}; b2 b = __builtin_convertvector(v, b2); return __builtin_bit_cast(unsigned, b); }
typedef short v4i16_t __attribute__((ext_vector_type(4)));
__device__ __forceinline__ s16x4 vtr(const LAS unsigned char* p) { return __builtin_bit_cast(s16x4, __builtin_amdgcn_ds_read_tr16_b64_v4i16((LAS v4i16_t*)p)); }
__device__ __forceinline__ void attn_unit(int b, int h, int qb, const bf16* QH, const bf16* KN, const bf16* KR, const bf16* VH, bf16* O  , LAS unsigned char* lds) {
    const int tid = threadIdx.x, lane = tid & 63, r32 = lane & 31, hi = lane >> 5, wid = __builtin_amdgcn_readfirstlane(tid >> 6);
    const size_t rowbase = (size_t)b * SEQ; const int q0 = qb * 256, NT = 4 * (qb + 1);
    const bf16* ksrc0 = KN + (rowbase + lane) * 1024 + h * 64 + wid * 8;
    const bf16* ksrc1 = KR + (rowbase + lane) * 32 + (wid & 3) * 8;
    const bf16* vsrc = VH + (rowbase + 16 * (wid & 3) + (lane >> 2)) * 1024 + h * 64 + (wid >> 2) * 32 + (lane & 3) * 8;
#define ATT_DMA(t, slot) do { \
        __builtin_amdgcn_global_load_lds((const unsigned*)(ksrc0 + (size_t)(t) * 64 * 1024), (LAS unsigned*)(lds + L_K + (slot) * KSLOT + wid * 1024), 16, 0, 0); \
        if (wid < 4) __builtin_amdgcn_global_load_lds((const unsigned*)(ksrc1 + (size_t)(t) * 64 * 32), (LAS unsigned*)(lds + L_K + (slot) * KSLOT + (8 + wid) * 1024), 16, 0, 0); \
        __builtin_amdgcn_global_load_lds((const unsigned*)(vsrc + (size_t)(t) * 64 * 1024), (LAS unsigned*)(lds + L_V + (slot) * VSLOT + wid * 1024), 16, 0, 0); } while (0)
    ATT_DMA(0, 0);
    const bf16* Qw = QH + (rowbase + q0 + wid * 32 + r32) * QW + h * DQK + hi * 8;
    bf16x8 qr[6];
#pragma unroll
    for (int d0 = 0; d0 < 6; ++d0) qr[d0] = *(const bf16x8*)(Qw + d0 * 16);
    f32x16 o[2];
#pragma unroll
    for (int r = 0; r < 16; ++r) { o[0][r] = 0.f; o[1][r] = 0.f; }
    float mold = -1.0e30f, lsum = 0.f;
    LAS float* wsf = (LAS float*)(lds + L_WS) + wid * 64;
    const int qrel = wid * 32 + r32;
    for (int t = 0; t < NT; ++t) {
        __syncthreads();
        const int slot = t & 1;
        if (t + 1 < NT) ATT_DMA(t + 1, slot ^ 1);
        f32x16 p0, p1;
#pragma unroll
        for (int r = 0; r < 16; ++r) { p0[r] = 0.f; p1[r] = 0.f; }
        const LAS unsigned char* kb = lds + L_K + slot * KSLOT + hi * 1024 + r32 * 16;
#pragma unroll
        for (int d0 = 0; d0 < 6; ++d0) { const bf16x8 b0 = *(const LAS bf16x8*)(kb + d0 * 2048), b1 = *(const LAS bf16x8*)(kb + d0 * 2048 + 512);
            p0 = __builtin_amdgcn_mfma_f32_32x32x16_bf16(b0, qr[d0], p0, 0, 0, 0); p1 = __builtin_amdgcn_mfma_f32_32x32x16_bf16(b1, qr[d0], p1, 0, 0, 0); }
        if (t >= NT - 4) { const int kbase = 64 * (t - (NT - 4)) + 4 * hi;
#pragma unroll
            for (int r = 0; r < 16; ++r) { const int kv = kbase + (r & 3) + 8 * (r >> 2); if (kv > qrel) p0[r] = -INFINITY; if (kv + 32 > qrel) p1[r] = -INFINITY; } }
        float rm = fmaxf(p0[0], p1[0]);
#pragma unroll
        for (int r = 1; r < 16; ++r) rm = fmaxf(rm, fmaxf(p0[r], p1[r]));
        rm = fmaxf(rm, __shfl_xor(rm, 32));
        const float mnew = fmaxf(mold, rm);
        if (__any(mnew > mold)) {
            const float fac = __builtin_amdgcn_exp2f(mold - mnew); lsum *= fac; mold = mnew;
            if (hi == 0) wsf[r32] = fac;
            LDS_WAIT(); asm volatile("" ::: "memory");
#pragma unroll
            for (int r = 0; r < 16; ++r) { const float f = wsf[crow(r, hi)]; o[0][r] *= f; o[1][r] *= f; }
        }
        float sacc = 0.f;
#pragma unroll
        for (int r = 0; r < 16; ++r) { p0[r] = __builtin_amdgcn_exp2f(p0[r] - mold); p1[r] = __builtin_amdgcn_exp2f(p1[r] - mold); sacc += p0[r] + p1[r]; }
        lsum += sacc;
        v4u pw[4];
        pw[0] = (v4u){cvtpk(p0[0], p0[1]), cvtpk(p0[2], p0[3]), cvtpk(p0[4], p0[5]), cvtpk(p0[6], p0[7])};
        pw[1] = (v4u){cvtpk(p0[8], p0[9]), cvtpk(p0[10], p0[11]), cvtpk(p0[12], p0[13]), cvtpk(p0[14], p0[15])};
        pw[2] = (v4u){cvtpk(p1[0], p1[1]), cvtpk(p1[2], p1[3]), cvtpk(p1[4], p1[5]), cvtpk(p1[6], p1[7])};
        pw[3] = (v4u){cvtpk(p1[8], p1[9]), cvtpk(p1[10], p1[11]), cvtpk(p1[12], p1[13]), cvtpk(p1[14], p1[15])};
        const LAS unsigned char* vb = lds + L_V + slot * VSLOT + ((lane >> 4) & 1) * 32 + (lane & 3) * 8 + (4 * hi + ((lane & 15) >> 2)) * 64;
#pragma unroll
        for (int d0 = 0; d0 < 2; ++d0)
#pragma unroll
            for (int ks = 0; ks < 4; ++ks) { const s16x4 lo = vtr(vb + d0 * 4096 + ks * 1024), hh = vtr(vb + d0 * 4096 + ks * 1024 + 512);
                const bf16x8 vf = (bf16x8){lo[0], lo[1], lo[2], lo[3], hh[0], hh[1], hh[2], hh[3]};
                o[d0] = __builtin_amdgcn_mfma_f32_32x32x16_bf16(__builtin_bit_cast(bf16x8, pw[ks]), vf, o[d0], 0, 0, 0); }
    }
    lsum += __shfl_xor(lsum, 32);
    if (hi == 0) wsf[32 + r32] = lsum;
    LDS_WAIT(); asm volatile("" ::: "memory");
    LAS bf16* stg = (LAS bf16*)(lds + L_OST) + wid * 2048;
#pragma unroll
    for (int r = 0; r < 16; ++r) { const int orow = crow(r, hi); const float rl = __builtin_amdgcn_rcpf(wsf[32 + orow]);
        stg[orow * 64 + r32] = (bf16)f2bf(o[0][r] * rl); stg[orow * 64 + 32 + r32] = (bf16)f2bf(o[1][r] * rl); }
    LDS_WAIT(); asm volatile("" ::: "memory");
    bf16* Ow = O + (rowbase + q0 + wid * 32) * NPROJ + h * 64;
#pragma unroll
    for (int i = 0; i < 4; ++i) { const int row = i * 8 + (lane >> 3), ch = lane & 7; const v4u v = *(const LAS v4u*)(stg + row * 64 + ch * 8); *(v4u*)(Ow + (size_t)row * NPROJ + ch * 8) = v; }
    LDS_WAIT();
#undef ATT_DMA
}
}

struct Args { const void* in[34]; float* out; unsigned char* ws; int ph_lo, ph_hi, li, pad; };
constexpr int N_PHASES = 16;

__global__ void __launch_bounds__(NWAVES * 64, 2) mk_fwd(Args args) {
    extern __shared__ __attribute__((aligned(16))) unsigned char lds_raw[];
    LAS unsigned char* lds = (LAS unsigned char*)lds_raw;
    volatile LAS unsigned* MISC = (volatile LAS unsigned*)(lds + MISC_OFF);
    const int tid = threadIdx.x, lane = tid & 63, wave = __builtin_amdgcn_readfirstlane(tid >> 6);
    const int G = gridDim.x, bx = blockIdx.x, vcu = (G % 8 == 0) ? (bx % 8) * (G / 8) + bx / 8 : bx;
    const int gw = vcu * NWAVES + wave, NGW = G * NWAVES;
    unsigned char* ws = args.ws; unsigned char* outb = (unsigned char*)args.out;
    unsigned* ctl = (unsigned*)(ws + WS_CTL);
#define x_in ((const float*)args.in[0])
#define mem_in ((const float*)args.in[1])
#define positions ((const int*)((const int*)args.in[2]))
#define w_in ((const float*)((const float*)args.in[3]))
#define b_in ((const float*)((const float*)args.in[4]))
#define gm_ln_g ((const float*)((const float*)args.in[5]))
#define gm_ln_b ((const float*)((const float*)args.in[6]))
#define gm_w_s ((const float*)((const float*)args.in[7]))
#define gm_b_s ((const float*)((const float*)args.in[8]))
#define w_gm_out ((const float*)((const float*)args.in[9]))
#define q_norm_g ((const float*)((const float*)args.in[10]))
#define kv_norm_g ((const float*)((const float*)args.in[11]))
#define w_uq ((const float*)((const float*)args.in[12]))
#define w_uk ((const float*)((const float*)args.in[13]))
#define w_uv ((const float*)((const float*)args.in[14]))
#define w_mla_out ((const float*)((const float*)args.in[15]))
#define w_o ((const float*)((const float*)args.in[16]))
#define ln1_g ((const float*)((const float*)args.in[17]))
#define ln1_b ((const float*)((const float*)args.in[18]))
#define w_mq ((const float*)((const float*)args.in[19]))
#define w_mk ((const float*)((const float*)args.in[20]))
#define w_mv ((const float*)((const float*)args.in[21]))
#define w_mo ((const float*)((const float*)args.in[22]))
#define ln2_g ((const float*)((const float*)args.in[23]))
#define ln2_b ((const float*)((const float*)args.in[24]))
#define w_gr ((const float*)((const float*)args.in[25]))
#define b_gr ((const float*)((const float*)args.in[26]))
#define w_er ((const float*)((const float*)args.in[27]))
#define b_er ((const float*)((const float*)args.in[28]))
#define w_eg ((const float*)((const float*)args.in[29]))
#define w_eu ((const float*)((const float*)args.in[30]))
#define w_ed ((const float*)((const float*)args.in[31]))
#define ln3_g ((const float*)((const float*)args.in[32]))
#define ln3_b ((const float*)((const float*)args.in[33]))
#define VSTAT ((float*)((float*)(ws + WS_VSTAT)))
#define RSQ ((float*)((float*)(ws + WS_RSQ)))
#define RSKV ((float*)((float*)(ws + WS_RSKV)))
#define BIASP ((float*)((float*)(ws + WS_BIASP)))
#define TOKE ((int*)((int*)(ws + WS_TOKE)))
#define TOKW ((float*)((float*)(ws + WS_TOKW)))
#define TOKP ((int*)((int*)(ws + WS_TOKP)))
#define ROWW ((float*)((float*)(ws + WS_ROWW)))
#define ROPE ((float*)((float*)(ws + WS_ROPE)))
#define WIN_T ((bf16*)((bf16*)(ws + WS_WIN)))
#define WGM_T ((bf16*)((bf16*)(ws + WS_WGM)))
#define WMLA_T ((bf16*)((bf16*)(ws + WS_WMLA)))
#define WO_T ((bf16*)((bf16*)(ws + WS_WO)))
#define WMQ_N ((bf16*)((bf16*)(ws + WS_WMQN)))
#define WMKV_T ((bf16*)((bf16*)(ws + WS_WMKV)))
#define WMO_T ((bf16*)((bf16*)(ws + WS_WMO)))
#define WUQ_T ((bf16*)((bf16*)(ws + WS_WUQ)))
#define WUKV_T ((bf16*)((bf16*)(ws + WS_WUKV)))
#define WTRIL ((bf16*)((bf16*)(ws + WS_WTRIL)))
#define WRH ((bf16*)((bf16*)(ws + WS_WRT)))
#define WRL ((bf16*)(WRH + 80 * 1024))
#define MB ((bf16*)((bf16*)(ws + WS_MB)))
#define KXVX ((bf16*)((bf16*)(ws + WS_KXVX)))
#define WQK ((bf16*)((bf16*)(ws + WS_WQK)))
#define VW ((bf16*)((bf16*)(ws + WS_VW)))
#define PROJ ((bf16*)((bf16*)(ws + WS_PROJ)))
#define XB ((bf16*)((bf16*)(ws + WS_XB)))
#define VH ((bf16*)((bf16*)(ws + WS_VH)))
#define MG ((bf16*)((bf16*)(ws + WS_MG)))
#define KN ((bf16*)((bf16*)(ws + WS_KN)))
#define X1 ((float*)((float*)(ws + WS_X1)))
#define X1B ((bf16*)((bf16*)(ws + WS_X1B)))
#define PX ((bf16*)((bf16*)(ws + WS_PX)))
#define X2 ((float*)((float*)(ws + WS_X2)))
#define WE2 ((bf16*)((bf16*)(ws + WS_WE2)))
#define XS ((bf16*)((bf16*)(ws + WS_XS)))
#define HS ((bf16*)((bf16*)(ws + WS_HS)))
#define YS ((bf16*)((bf16*)(ws + WS_YS)))
#define QH ((bf16*)((bf16*)(outb + OUT_QH)))
#define KR ((bf16*)((bf16*)(outb + OUT_KR)))
#define MG32 ((float*)((float*)(outb + OUT_MG32)))
#define X2B ((bf16*)((bf16*)(outb + OUT_X2B)))
#define WE1 ((bf16*)((bf16*)(outb + OUT_WE1)))
    for (int u = tid; u < (LDS_BYTES - MISC_OFF) / 4; u += NWAVES * 64) ((LAS unsigned*)(lds + MISC_OFF))[u] = 0u;
    __syncthreads();
    const bool one_launch = (MK_N_LAUNCHES == 1);
    XcdBarrier bar; bar.bar = ctl + CW_BAR; bar.x = 0; bar.st = nullptr;
    if (one_launch) bar = xcd_barrier_post(ctl + CW_BAR, MISC + 8);
    const int lo = args.ph_lo, hi = args.ph_hi;
#ifndef SUBMASK
#define SUBMASK 0xFF
#endif
#ifndef PHASE_MASK
#define PHASE_MASK 0xFFFF
#endif
#define IN(k) ((((PHASE_MASK) >> (k)) & 1) && lo <= (k) && (k) < hi)
#define SEAM(k) do { if (IN(k) && IN((k) + 1)) xcd_barrier(bar); } while (0)
    LAS float* scr = (LAS float*)(lds + wave * 16384);
    LAS unsigned char* ldsx = lds + XSCR_OFF;

    if (IN(0)) {
        tr_matrix(w_in, 1024, IN_COLS, NPROJ, WIN_T, 1024, 0, ColWin{}, nullptr, scr, lane, gw, NGW);
        tr_matrix(w_gm_out, 1024, 1024, 1024, WGM_T, 1024, 0, ColIdent{0}, nullptr, scr, lane, gw, NGW);
        tr_matrix(w_mla_out, 1024, 1024, 1024, WMLA_T, 1024, 0, ColIdent{0}, nullptr, scr, lane, gw, NGW);
        tr_matrix(w_o, 1024, 1024, 1024, WO_T, 1024, 0, ColIdent{0}, nullptr, scr, lane, gw, NGW);
        tr_matrix(w_mk, 1024, 1024, 1024, WMKV_T, 1024, 0, ColIdent{0}, nullptr, scr, lane, gw, NGW);
        tr_matrix(w_mv, 1024, 1024, 1024, WMKV_T, 1024, 1024, ColIdent{0}, nullptr, scr, lane, gw, NGW);
        tr_matrix(w_mo, 1024, 1024, 1024, WMO_T, 1024, 0, ColIdent{0}, nullptr, scr, lane, gw, NGW);
        tr_matrix(w_uq, QLORA, QW, QW, WUQ_T, QLORA, 0, ColWuq{}, q_norm_g, scr, lane, gw, NGW);
        tr_matrix(w_uk, KVLORA, 1024, 1024, WUKV_T, KVLORA, 0, ColIdent{0}, kv_norm_g, scr, lane, gw, NGW);
        tr_matrix(w_uv, KVLORA, 1024, 1024, WUKV_T, KVLORA, 1024, ColIdent{0}, kv_norm_g, scr, lane, gw, NGW);
        const size_t gt = (size_t)vcu * 512 + tid, NT_ = (size_t)G * 512;
        for (size_t i = gt; i < (size_t)M * 1024 / 8; i += NT_) { const f32x4 a = *(const f32x4*)(x_in + i * 8), b = *(const f32x4*)(x_in + i * 8 + 4); v4u o; o.x = pk2(a[0], a[1]); o.y = pk2(a[2], a[3]); o.z = pk2(b[0], b[1]); o.w = pk2(b[2], b[3]); *(v4u*)(XB + i * 8) = o; }
        for (size_t i = gt; i < (size_t)MROWS * 1024 / 8; i += NT_) { const f32x4 a = *(const f32x4*)(mem_in + i * 8), b = *(const f32x4*)(mem_in + i * 8 + 4); v4u o; o.x = pk2(a[0], a[1]); o.y = pk2(a[2], a[3]); o.z = pk2(b[0], b[1]); o.w = pk2(b[2], b[3]); *(v4u*)(MB + i * 8) = o; }
        for (size_t i = gt; i < (size_t)1024 * 1024 / 8; i += NT_) { const f32x4 a = *(const f32x4*)(w_mq + i * 8), b = *(const f32x4*)(w_mq + i * 8 + 4); v4u o; o.x = pk2(a[0], a[1]); o.y = pk2(a[2], a[3]); o.z = pk2(b[0], b[1]); o.w = pk2(b[2], b[3]); *(v4u*)(WMQ_N + i * 8) = o; }
        for (size_t i = gt; i < (size_t)8 * 128 * 128; i += NT_) { const int s = (int)(i & 127), t = (int)((i >> 7) & 127); WTRIL[i] = (bf16)f2bf(s <= t ? gm_w_s[i] : 0.f); }
        for (size_t i = gt; i < (size_t)80 * 1024; i += NT_) { const int n = (int)(i >> 10), k = (int)(i & 1023); const float wv = n < 8 ? w_gr[k * 8 + n] : (n < 72 ? w_er[k * 64 + (n - 8)] : 0.f);
            const unsigned h = f2bf(wv); WRH[i] = (bf16)h; WRL[i] = (bf16)f2bf(wv - __builtin_bit_cast(float, h << 16)); }
        for (size_t i = gt; i < (size_t)NPROJ; i += NT_) { const int sc = ColWin{}((int)i); BIASP[i] = sc >= 0 ? b_in[sc] : 0.f; }
        for (size_t i = gt; i < (size_t)M * 16; i += NT_) { const int row = (int)(i >> 4), j = (int)(i & 15); const float invf = exp2f(-(float)j * (13.287712379549449f / 16.0f));
            const float angf = (float)positions[row] * invf; const double ang = (double)angf; const double kq = rint(ang * 0.15915494309189535); const float r = (float)(ang - kq * 6.283185307179586);
            ROPE[i * 2] = cosf(r); ROPE[i * 2 + 1] = sinf(r); }
        __syncthreads();
    }
    SEAM(0);
    if (IN(1)) {
        pg8::Gemm g{1024, 1024, 1024}; GenOrder S; S.init(M, NPROJ, G, bx, XB, 1024, WIN_T, 1024);
        pg8::EpiF8<F_inproj> E{{PROJ, BIASP}};
        pg8::gemm_phase<pg8::EpiF8<F_inproj>, GenOrder, true, true>(lds, ldsx, g, S, E);
    }
    SEAM(1);
    if (IN(2)) {
        for (int row = gw; row < M; row += NGW) {
            const bf16* pr = PROJ + (size_t)row * NPROJ;
            float a[8], b[8]; unpack8(*(const v4u*)(pr + PC_V + 8 * lane), a); unpack8(*(const v4u*)(pr + PC_V + 512 + 8 * lane), b);
            float s = 0.f;
#pragma unroll
            for (int i = 0; i < 8; ++i) s += a[i] + b[i];
            const float mean = wave_sum(s) * (1.f / 1024.f); float s2 = 0.f;
#pragma unroll
            for (int i = 0; i < 8; ++i) { const float da = a[i] - mean, db = b[i] - mean; s2 += da * da + db * db; }
            const float rstd = 1.0f / sqrtf(wave_sum(s2) * (1.f / 1024.f) + LN_EPS);
            float q2 = 0.f, k2 = 0.f;
            if (lane < 48) { float c[8]; unpack8(*(const v4u*)(pr + PC_CQ + 8 * lane), c);
#pragma unroll
                for (int i = 0; i < 8; ++i) q2 += c[i] * c[i]; }
            if (lane < 32) { float c[8]; unpack8(*(const v4u*)(pr + PC_CKV + 8 * lane), c);
#pragma unroll
                for (int i = 0; i < 8; ++i) k2 += c[i] * c[i]; }
            q2 = wave_sum(q2); k2 = wave_sum(k2);
            if (lane == 0) { *(f32x2*)(VSTAT + (size_t)row * 2) = (f32x2){mean, rstd}; RSQ[row] = 1.0f / sqrtf(q2 * (1.f / QLORA) + RMS_EPS); RSKV[row] = 1.0f / sqrtf(k2 * (1.f / KVLORA) + RMS_EPS); }
            if (lane < 4) { float c[8]; unpack8(*(const v4u*)(pr + PC_KR + 8 * lane), c); const f32x4 c0 = *(const f32x4*)(ROPE + ((size_t)row * 16 + 4 * lane) * 2), c1 = *(const f32x4*)(ROPE + ((size_t)row * 16 + 4 * lane) * 2 + 4);
                const float cs[8] = {c0[0], c0[1], c0[2], c0[3], c1[0], c1[1], c1[2], c1[3]}; float o[8];
#pragma unroll
                for (int e = 0; e < 4; ++e) { o[2 * e] = c[2 * e] * cs[2 * e] - c[2 * e + 1] * cs[2 * e + 1]; o[2 * e + 1] = c[2 * e + 1] * cs[2 * e] + c[2 * e] * cs[2 * e + 1]; }
                st16(KR + (size_t)row * 32 + 8 * lane, o); }
        }
    }
    SEAM(2);
    if (IN(3)) {
        if (SUBMASK & 1) gmlp_phase(lds, PROJ, VSTAT, gm_ln_g, gm_ln_b, WTRIL, gm_b_s, vcu, G);
        if (SUBMASK & 2) { pg8::Gemm g{NPROJ, QLORA, QLORA}; GenOrder S; S.init(M, QW, G, bx, PROJ + PC_CQ, NPROJ, WUQ_T, QLORA);
          pg8::EpiF8<F_q> E{{QH, RSQ, ROPE}}; pg8::gemm_phase<pg8::EpiF8<F_q>, GenOrder, true, true>(lds, ldsx, g, S, E); }
        if (SUBMASK & 4) { pg8::Gemm g{NPROJ, KVLORA, KVLORA}; GenOrder S; S.init(M, 2048, G, bx, PROJ + PC_CKV, NPROJ, WUKV_T, KVLORA);
          pg8::EpiF8<F_kv> E{{KN, VH, RSKV}}; pg8::gemm_phase<pg8::EpiF8<F_kv>, GenOrder, true, true>(lds, ldsx, g, S, E); }
        if (SUBMASK & 8) { pg8::Gemm g{1024, 1024, 1024}; GenOrder S; S.init(MROWS, 2048, G, bx, MB, 1024, WMKV_T, 1024);
          pg8::EpiF8<F_store> E{{KXVX, 2048, 1.0f}}; pg8::gemm_phase<pg8::EpiF8<F_store>, GenOrder, true, true>(lds, ldsx, g, S, E); }
    }
    SEAM(3);
    if (IN(4)) {
        if (SUBMASK & 16) for (int i = 0; i < 8; ++i) { const int bh = vcu >> 1, s = vcu & 1, k2 = i >> 1; const int qb = (i & 1) ? (4 * k2 + 3 - s) : (4 * k2 + s);
            if (vcu < 256) att::attn_unit(bh >> 4, bh & 15, qb, QH, KN, KR, VH, PROJ + PC_V, lds); }
        __syncthreads();
        if (SUBMASK & 32) { pg8::Gemm g{2048, 1024, 256}; GenOrder S; S.init(8192, 1024, G, bx, KXVX, 2048, WMQ_N, 1024, 2);
          pg8::EpiF8<F_store> E{{WQK, 1024, C2_MEM}}; pg8::gemm_phase<pg8::EpiF8<F_store>, GenOrder, true, true>(lds, ldsx, g, S, E); }
        if (SUBMASK & 64) { pg8::Gemm g{1024, 2048, 256}; GenOrder S; S.init(8192, 1024, G, bx, WMO_T, 1024, KXVX + 1024, 2048, 3);
          pg8::EpiF8<F_store> E{{VW, 1024, 1.0f}}; pg8::gemm_phase<pg8::EpiF8<F_store>, GenOrder, true, true>(lds, ldsx, g, S, E); }
    }
    SEAM(4);
    if (IN(5)) {
        { pg8::Gemm g{NPROJ, 1024, 1024}; GenOrder S; S.init(M, 1024, G, bx, PROJ + PC_U, NPROJ, WGM_T, 1024);
          pg8::EpiF8<F_mg1> E{{PROJ, MG32}}; pg8::gemm_phase<pg8::EpiF8<F_mg1>, GenOrder, true, true>(lds, ldsx, g, S, E); }
        { pg8::Gemm g{NPROJ, 1024, 1024}; GenOrder S; S.init(M, 1024, G, bx, PROJ + PC_V, NPROJ, WMLA_T, 1024);
          pg8::EpiF8<F_mg2> E{{PROJ, MG32, MG}}; pg8::gemm_phase<pg8::EpiF8<F_mg2>, GenOrder, true, true>(lds, ldsx, g, S, E); }
    }
    SEAM(5);
    if (IN(6)) {
        pg8::Gemm g{1024, 1024, 1024}; GenOrder S; S.init(M, 1024, G, bx, MG, 1024, WO_T, 1024);
        pg8::EpiF8<F_res> E{{x_in, X1}}; pg8::gemm_phase<pg8::EpiF8<F_res>, GenOrder, true, true>(lds, ldsx, g, S, E);
    }
    SEAM(6);
    if (IN(7)) {
        for (int row = gw; row < M; row += NGW) { float* p = X1 + (size_t)row * 1024; f32x4 v[4];
#pragma unroll
            for (int j = 0; j < 4; ++j) v[j] = *(const f32x4*)(p + 256 * j + 4 * lane);
            ln_row_store(v, ln1_g, ln1_b, p, X1B + (size_t)row * 1024, lane); }
        for (int it = gw; it < NEXP * 256; it += NGW) { const int e = it >> 8, kb = (it & 255) >> 4, n0 = 32 * (it & 15);
            const float* W = (((n0 >> 7) & 1) ? w_eu : w_eg) + (size_t)e * 1024 * DEXP;
            tr_item(W, DEXP, WE1 + (size_t)e * 512 * 1024, 1024, 64 * kb, n0, ColIdent{(n0 >> 8) * 128 + (n0 & 127) - n0}, nullptr, scr, lane); }
        for (int it = gw; it < NEXP * 128; it += NGW) { const int e = it >> 7, kb = (it & 127) >> 5, n0 = 32 * (it & 31);
            tr_item(w_ed + (size_t)e * DEXP * 1024, 1024, WE2 + (size_t)e * 1024 * DEXP, DEXP, 64 * kb, n0, ColIdent{0}, nullptr, scr, lane); }
        __syncthreads();
    }
    SEAM(7);
    if (IN(8)) {
        pg8::Gemm g{1024, 1024, 1024}; GenOrder S; S.init(M, 1024, G, bx, X1B, 1024, WQK, 1024, 1, 16, (size_t)1024 * 1024 * 2);
        EpiSoftmax E{PX}; pg8::gemm_phase<EpiSoftmax, GenOrder, true, true>(lds, ldsx, g, S, E);
    }
    SEAM(8);
    if (IN(9)) {
        pg8::Gemm g{1024, 1024, 1024}; GenOrder S; S.init(M, 1024, G, bx, PX, 1024, VW, 1024, 1, 16, (size_t)1024 * 1024 * 2);
        pg8::EpiF8<F_res> E{{X1, X2}}; pg8::gemm_phase<pg8::EpiF8<F_res>, GenOrder, true, true>(lds, ldsx, g, S, E);
    }
    SEAM(9);
    if (IN(10)) {
        for (int row = gw; row < M; row += NGW) { float* p = X2 + (size_t)row * 1024; f32x4 v[4];
#pragma unroll
            for (int j = 0; j < 4; ++j) v[j] = *(const f32x4*)(p + 256 * j + 4 * lane);
            ln_row_store(v, ln2_g, ln2_b, p, X2B + (size_t)row * 1024, lane); }
    }
    SEAM(10);
    if (IN(11)) {
        LAS float* LG = (LAS float*)(lds + wave * 5120);
        for (int grp = gw; grp < M / 16; grp += NGW) {
            const int tok0 = grp * 16;
            f32x4 acc[5];
#pragma unroll
            for (int nb = 0; nb < 5; ++nb) acc[nb] = (f32x4){0.f, 0.f, 0.f, 0.f};
            for (int ks = 0; ks < 32; ++ks) {
                const float* xp = X2 + (size_t)(tok0 + (lane & 15)) * 1024 + 32 * ks + 8 * (lane >> 4);
                const f32x4 a0 = *(const f32x4*)xp, a1 = *(const f32x4*)(xp + 4); const float xv[8] = {a0[0], a0[1], a0[2], a0[3], a1[0], a1[1], a1[2], a1[3]};
                bf16x8 ah, al;
#pragma unroll
                for (int i = 0; i < 8; ++i) { const unsigned h = f2bf(xv[i]); ah[i] = (short)h; al[i] = (short)f2bf(xv[i] - __builtin_bit_cast(float, h << 16)); }
#pragma unroll
                for (int nb = 0; nb < 5; ++nb) { const size_t wo = (size_t)(16 * nb + (lane & 15)) * 1024 + 32 * ks + 8 * (lane >> 4);
                    const bf16x8 bh = *(const bf16x8*)(WRH + wo), bl = *(const bf16x8*)(WRL + wo);
                    acc[nb] = __builtin_amdgcn_mfma_f32_16x16x32_bf16(ah, bh, acc[nb], 0, 0, 0); acc[nb] = __builtin_amdgcn_mfma_f32_16x16x32_bf16(al, bh, acc[nb], 0, 0, 0); acc[nb] = __builtin_amdgcn_mfma_f32_16x16x32_bf16(ah, bl, acc[nb], 0, 0, 0); }
            }
#pragma unroll
            for (int nb = 0; nb < 5; ++nb)
#pragma unroll
                for (int r = 0; r < 4; ++r) LG[(4 * (lane >> 4) + r) * 80 + 16 * nb + (lane & 15)] = acc[nb][r];
            LDS_WAIT(); asm volatile("" ::: "memory");
            if (lane < 16) { const LAS float* L = LG + lane * 80; const int t = tok0 + lane;
                float gmax = L[0] + b_gr[0]; int gsel = 0; float gl[8]; gl[0] = gmax;
#pragma unroll
                for (int i = 1; i < 8; ++i) { gl[i] = L[i] + b_gr[i]; if (gl[i] > gmax) { gmax = gl[i]; gsel = i; } }
                float den = 0.f;
#pragma unroll
                for (int i = 0; i < 8; ++i) den += __expf(gl[i] - gmax);
                const float gwt = 1.0f / den;
                float v0 = -3.0e38f, v1 = -3.0e38f; int i0 = 0, i1 = 0;
#pragma unroll
                for (int i = 0; i < 8; ++i) { const float ev = L[8 + gsel * 8 + i] + b_er[gsel * 8 + i];
                    if (ev > v0) { v1 = v0; i1 = i0; v0 = ev; i0 = i; } else if (ev > v1) { v1 = ev; i1 = i; } }
                const float w0 = gwt / (1.0f + __expf(v1 - v0)), w1 = gwt - w0; const int e0 = gsel * 8 + i0, e1 = gsel * 8 + i1;
                const unsigned p0 = __hip_atomic_fetch_add(ctl + CW_CNT + e0, 1u, RLX_AGENT), p1 = __hip_atomic_fetch_add(ctl + CW_CNT + e1, 1u, RLX_AGENT);
                TOKE[2 * t] = e0; TOKE[2 * t + 1] = e1; TOKW[2 * t] = w0; TOKW[2 * t + 1] = w1; TOKP[2 * t] = (int)p0; TOKP[2 * t + 1] = (int)p1; }
            LDS_WAIT(); asm volatile("" ::: "memory");
        }
    }
    SEAM(11);
    if (IN(12)) {
        LAS int* PS = (LAS int*)lds;
        if (tid < 64) { const int c = (int)__hip_atomic_load(ctl + CW_CNT + tid, RLX_AGENT), nt_ = (c + 255) >> 8; int inc = nt_;
#pragma unroll
            for (int o = 1; o < 64; o <<= 1) { const int y = __shfl_up(inc, o); if (lane >= o) inc += y; }
            const int excl = inc - nt_; PS[tid] = excl;
            if (bx == 0) { for (int k = 0; k < nt_; ++k) __hip_atomic_store(ctl + CW_TILEE + excl + k, (unsigned)tid, RLX_AGENT); if (tid == 63) __hip_atomic_store(ctl + CW_NTILES, (unsigned)inc, RLX_AGENT); } }
        __syncthreads();
        for (int t = gw; t < M; t += NGW) {
            const int e0 = TOKE[2 * t], e1 = TOKE[2 * t + 1], p0 = TOKP[2 * t], p1 = TOKP[2 * t + 1];
            const int r0 = PS[e0] * 256 + p0, r1 = PS[e1] * 256 + p1;
            const v4u* src = (const v4u*)(X2B + (size_t)t * 1024); const v4u a = src[lane], b = src[64 + lane];
            v4u* d0 = (v4u*)(XS + (size_t)r0 * 1024); v4u* d1 = (v4u*)(XS + (size_t)r1 * 1024);
            d0[lane] = a; d0[64 + lane] = b; d1[lane] = a; d1[64 + lane] = b;
            if (lane == 0) { ROWW[r0] = TOKW[2 * t]; ROWW[r1] = TOKW[2 * t + 1]; TOKP[2 * t] = r0; TOKP[2 * t + 1] = r1; }
        }
        __syncthreads();
    }
    SEAM(12);
    if (IN(13)) {
        const int ntl = (int)__builtin_amdgcn_readfirstlane(__hip_atomic_load(ctl + CW_NTILES, RLX_AGENT));
        pg8::Gemm g{1024, 1024, 1024}; GenOrder S; S.init(ntl * 256, 512, G, bx, XS, 1024, WE1, 1024, 4, 1, (size_t)512 * 1024 * 2); S.tile_e = ctl + CW_TILEE;
        EpiSwiglu E{HS}; pg8::gemm_phase<EpiSwiglu, GenOrder, true, true>(lds, ldsx, g, S, E);
    }
    SEAM(13);
    if (IN(14)) {
        const int ntl = (int)__builtin_amdgcn_readfirstlane(__hip_atomic_load(ctl + CW_NTILES, RLX_AGENT));
        pg8::Gemm g{DEXP, DEXP, DEXP}; GenOrder S; S.init(ntl * 256, 1024, G, bx, HS, DEXP, WE2, DEXP, 4, 1, (size_t)1024 * DEXP * 2); S.tile_e = ctl + CW_TILEE;
        pg8::EpiF8<F_down> E{{YS, ROWW}}; pg8::gemm_phase<pg8::EpiF8<F_down>, GenOrder, true, true>(lds, ldsx, g, S, E);
    }
    SEAM(14);
    if (IN(15)) {
        for (int t = gw; t < M; t += NGW) {
            const int r0 = TOKP[2 * t], r1 = TOKP[2 * t + 1]; const float* p = X2 + (size_t)t * 1024; const bf16* y0 = YS + (size_t)r0 * 1024; const bf16* y1 = YS + (size_t)r1 * 1024; f32x4 v[4];
#pragma unroll
            for (int j = 0; j < 4; ++j) { const f32x4 a = *(const f32x4*)(p + 256 * j + 4 * lane); const v2u c = *(const v2u*)(y0 + 256 * j + 4 * lane), d = *(const v2u*)(y1 + 256 * j + 4 * lane);
                v[j] = (f32x4){ALPHA * a[0] + bflo(c.x) + bflo(d.x), ALPHA * a[1] + bfhi(c.x) + bfhi(d.x), ALPHA * a[2] + bflo(c.y) + bflo(d.y), ALPHA * a[3] + bfhi(c.y) + bfhi(d.y)}; }
            ln_row_store(v, ln3_g, ln3_b, args.out + (size_t)t * 1024, nullptr, lane);
        }
    }
#undef IN
#undef SEAM
#undef x_in
#undef mem_in
#undef positions
#undef w_in
#undef b_in
#undef gm_ln_g
#undef gm_ln_b
#undef gm_w_s
#undef gm_b_s
#undef w_gm_out
#undef q_norm_g
#undef kv_norm_g
#undef w_uq
#undef w_uk
#undef w_uv
#undef w_mla_out
#undef w_o
#undef ln1_g
#undef ln1_b
#undef w_mq
#undef w_mk
#undef w_mv
#undef w_mo
#undef ln2_g
#undef ln2_b
#undef w_gr
#undef b_gr
#undef w_er
#undef b_er
#undef w_eg
#undef w_eu
#undef w_ed
#undef ln3_g
#undef ln3_b
#undef VSTAT
#undef RSQ
#undef RSKV
#undef BIASP
#undef TOKE
#undef TOKW
#undef TOKP
#undef ROWW
#undef ROPE
#undef WIN_T
#undef WGM_T
#undef WMLA_T
#undef WO_T
#undef WMQ_N
#undef WMKV_T
#undef WMO_T
#undef WUQ_T
#undef WUKV_T
#undef WTRIL
#undef WRH
#undef WRL
#undef MB
#undef KXVX
#undef WQK
#undef VW
#undef PROJ
#undef XB
#undef VH
#undef MG
#undef KN
#undef X1
#undef X1B
#undef PX
#undef X2
#undef WE2
#undef XS
#undef HS
#undef YS
#undef QH
#undef KR
#undef MG32
#undef X2B
#undef WE1
}

extern "C" void kernel_launch(void* const* d_in, const int* in_sizes, int n_in, void* d_out, int out_size, void* d_ws, size_t ws_size, hipStream_t stream) {
    static int grid = 0;
    if (grid == 0) {
        if (n_in != 34 || out_size != M * 1024 || ws_size < WS_END) { fprintf(stderr, "kernel_launch: unexpected shapes (n_in %d out %d ws %zu)\n", n_in, out_size, ws_size); grid = -1; return; }
        int dev = 0, cus = 0;
        if (hipGetDevice(&dev) != hipSuccess || hipDeviceGetAttribute(&cus, hipDeviceAttributeMultiprocessorCount, dev) != hipSuccess) { grid = -1; return; }
        if (hipFuncSetAttribute((const void*)mk_fwd, hipFuncAttributeMaxDynamicSharedMemorySize, LDS_BYTES) != hipSuccess) { fprintf(stderr, "kernel_launch: hipFuncSetAttribute failed\n"); grid = -1; return; }
        int per_cu = 0; (void)hipOccupancyMaxActiveBlocksPerMultiprocessor(&per_cu, (const void*)mk_fwd, NWAVES * 64, LDS_BYTES); (void)hipGetLastError();
        grid = cus;
        if (grid != 256) fprintf(stderr, "kernel_launch: note: %d CUs\n", grid);
    }
    if (grid < 0) return;
    (void)hipMemsetAsync((char*)d_ws + WS_CTL, 0, CTL_ZERO_BYTES, stream);
    Args a{};
    for (int i = 0; i < 34; ++i) a.in[i] = d_in[i];
    a.out = (float*)d_out; a.ws = (unsigned char*)d_ws;
    if (MK_N_LAUNCHES == 1) { a.ph_lo = 0; a.ph_hi = N_PHASES; a.li = 0; hipLaunchKernelGGL(mk_fwd, dim3(grid), dim3(NWAVES * 64), LDS_BYTES, stream, a); }
    else { for (int li = 0; li < N_PHASES; ++li) { a.ph_lo = li; a.ph_hi = li + 1; a.li = li; hipLaunchKernelGGL(mk_fwd, dim3(grid), dim3(NWAVES * 64), LDS_BYTES, stream, a); } }
}
```
